# Optimizing an MI355X kernel written in HIP

```python
import math
import jax
import jax.numpy as jnp
from jax import lax
import numpy as np

D_MODEL = 1024
BATCH = 8
SEQ = 2048
DEPTH = 2

GRID_W = 64
CTX_LEN = 256
HEAD_DIM = 64
ROPE_THETA = 10000.0
EPS = 1e-6
Q_BLOCK = 128
FFN_DIM = 2816
N_MOD = 9

A_Q_HEADS = 4
A_KV_HEADS = 2
WINDOW = 128
B_Q_HEADS = 4
B_KV_HEADS = 2
C_HEADS = 4
C_Q_LORA = 256
C_KV_LORA = 128
C_NOPE = 64
C_ROPE = 32
C_V = 64
D_HEADS = 4
D_HEAD_DIM = 64
D_STATE = 128
D_GROUPS = 2
D_CONV = 5
SSD_CHUNK = 128

MIX_A = A_Q_HEADS * HEAD_DIM
MIX_B = B_Q_HEADS * HEAD_DIM
MIX_C = C_HEADS * C_V
MIX_D = D_HEADS * D_HEAD_DIM
MIX_WIDTH = MIX_A + MIX_B + MIX_C + MIX_D
IN_A = (A_Q_HEADS + 2 * A_KV_HEADS) * HEAD_DIM
IN_B = (B_Q_HEADS + 2 * B_KV_HEADS) * HEAD_DIM
IN_C = C_Q_LORA + C_KV_LORA + C_ROPE
D_CONV_CH = MIX_D + 2 * D_GROUPS * D_STATE
IN_D = MIX_D + D_CONV_CH + 2 * D_HEADS
IN_WIDTH = IN_A + IN_B + IN_C + IN_D

kernel_name = "hybrid_prefix_dit_block"


def _rms(x, g):
    xf = x.astype(jnp.float32)
    y = xf * lax.rsqrt(jnp.mean(xf * xf, axis=-1, keepdims=True) + EPS)
    return (y * g.astype(jnp.float32)).astype(x.dtype)


def _modulate(n, shift, scale):
    return n * (1.0 + scale) + shift


def _swiglu(n, wi, wo):
    a, b = jnp.split(n @ wi, 2, axis=-1)
    return (jax.nn.silu(a) * b) @ wo


def _ffn_half(h, mods, norm_g, wi, wo):
    shift, scale, gate = mods
    n = _modulate(_rms(h, norm_g), shift, scale)
    return h + 0.5 * gate * _swiglu(n, wi, wo)


def _axial_angles(seq_len, rot_dim):
    rows = seq_len // GRID_W
    r = jnp.repeat(jnp.arange(rows, dtype=jnp.float32), GRID_W)
    col = jnp.tile(jnp.arange(GRID_W, dtype=jnp.float32), rows)
    axis_dim = rot_dim // 2
    inv = ROPE_THETA ** (-jnp.arange(0, axis_dim, 2, dtype=jnp.float32) / axis_dim)
    return (r[:, None] * inv[None, :], col[:, None] * inv[None, :])


def _rope_axis(x, ang):
    shape = (1, ang.shape[0]) + (1,) * (x.ndim - 3) + (ang.shape[1],)
    cos = jnp.cos(ang).reshape(shape)
    sin = jnp.sin(ang).reshape(shape)
    x1, x2 = jnp.split(x.astype(jnp.float32), 2, axis=-1)
    return jnp.concatenate([x1 * cos - x2 * sin, x2 * cos + x1 * sin], axis=-1).astype(x.dtype)


def _rope_2d(x, angs):
    xr, xc = jnp.split(x, 2, axis=-1)
    return jnp.concatenate([_rope_axis(xr, angs[0]), _rope_axis(xc, angs[1])], axis=-1)


def _attend(q, k, v, scale, sink=None):
    s = jnp.einsum('bqkgd,btkd->bkgqt', q, k).astype(jnp.float32) * scale
    if sink is not None:
        col = jnp.broadcast_to(sink.astype(jnp.float32)[None, :, :, None, None], s.shape[:-1] + (1,))
        p = jax.nn.softmax(jnp.concatenate([s, col], axis=-1), axis=-1)[..., :-1]
    else:
        p = jax.nn.softmax(s, axis=-1)
    return jnp.einsum('bkgqt,btke->bqkge', p.astype(v.dtype), v)


def _attend_blocked(q, k, v, scale):
    bsz, s = q.shape[:2]
    nb = s // Q_BLOCK
    qb = jnp.moveaxis(q.reshape((bsz, nb, Q_BLOCK) + q.shape[2:]), 1, 0)
    out = lax.map(lambda qi: _attend(qi, k, v, scale), qb)
    return jnp.moveaxis(out, 0, 1).reshape((bsz, s) + out.shape[3:])


def _window_attend(q, k, v, kc, vc, sink, scale):
    bsz, s = q.shape[:2]
    nb = s // WINDOW

    def bands(t):
        tp = jnp.pad(t, ((0, 0), (WINDOW, WINDOW), (0, 0), (0, 0)))
        tb = tp.reshape((bsz, nb + 2, WINDOW) + t.shape[2:])
        return jnp.concatenate([tb[:, :-2], tb[:, 1:-1], tb[:, 2:]], axis=2)

    kb, vb = bands(k), bands(v)
    qb = q.reshape((bsz, nb, WINDOW) + q.shape[2:])
    blk = jnp.arange(nb)[:, None] * WINDOW
    qpos = blk + jnp.arange(WINDOW)[None, :]
    kpos = blk - WINDOW + jnp.arange(3 * WINDOW)[None, :]
    valid = ((jnp.abs(qpos[:, :, None] - kpos[:, None, :]) <= WINDOW)
             & (kpos >= 0)[:, None, :] & (kpos < s)[:, None, :])
    s_loc = jnp.einsum('bnqkgd,bnjkd->bnkgqj', qb, kb).astype(jnp.float32) * scale
    s_loc = jnp.where(valid[None, :, None, None], s_loc, -jnp.inf)
    s_ctx = jnp.einsum('bnqkgd,bckd->bnkgqc', qb, kc).astype(jnp.float32) * scale
    s_sink = jnp.broadcast_to(sink.astype(jnp.float32)[None, None, :, :, None, None], s_loc.shape[:-1] + (1,))
    p = jax.nn.softmax(jnp.concatenate([s_loc, s_ctx, s_sink], axis=-1), axis=-1)
    p_loc = p[..., :3 * WINDOW].astype(v.dtype)
    p_ctx = p[..., 3 * WINDOW:3 * WINDOW + kc.shape[1]].astype(v.dtype)
    out = (jnp.einsum('bnkgqj,bnjkd->bnqkgd', p_loc, vb)
           + jnp.einsum('bnkgqc,bckd->bnqkgd', p_ctx, vc))
    return out.reshape((bsz, s) + out.shape[3:])


def _dwconv_centred(u, w, b):
    ch = u.shape[-1]
    y = lax.conv_general_dilated(u, w.reshape(w.shape[0], 1, ch).astype(u.dtype), window_strides=(1,),
                                 padding=[(D_CONV // 2, D_CONV // 2)],
                                 dimension_numbers=('NWC', 'WIO', 'NWC'), feature_group_count=ch)
    return y + b


def _ssd(x, dt, a_neg, bh, ch, h0):
    bsz, n, nh, hp = x.shape
    nc = n // SSD_CHUNK

    def chunk(t):
        return t.astype(jnp.float32).reshape((bsz, nc, SSD_CHUNK) + t.shape[2:])

    a = chunk(dt * a_neg)
    xdt = chunk(x.astype(jnp.float32) * dt[..., None])
    bc, cc = chunk(bh), chunk(ch)
    a_cs = jnp.cumsum(a, axis=2)
    seg = a_cs[:, :, :, None, :] - a_cs[:, :, None, :, :]
    lower = jnp.tril(jnp.ones((SSD_CHUNK, SSD_CHUNK), dtype=bool))
    decay = jnp.exp(jnp.where(lower[None, None, :, :, None], seg, -jnp.inf))
    scores = jnp.einsum('bcihn,bcjhn->bcijh', cc, bc) * decay
    y_diag = jnp.einsum('bcijh,bcjhp->bcihp', scores, xdt)
    decay_to_end = jnp.exp(a_cs[:, :, -1:, :] - a_cs)
    states = jnp.einsum('bcjhn,bcjh,bcjhp->bchpn', bc, decay_to_end, xdt)
    chunk_decay = jnp.exp(a_cs[:, :, -1, :])

    def step(h, inp):
        st, d = inp
        return d[:, :, None, None] * h + st, h

    h_final, h_in = lax.scan(step, h0, (jnp.swapaxes(states, 0, 1), jnp.swapaxes(chunk_decay, 0, 1)))
    h_in = jnp.swapaxes(h_in, 0, 1)
    y_off = jnp.einsum('bcihn,bchpn->bcihp', cc, h_in) * jnp.exp(a_cs)[..., None]
    y = (y_diag + y_off).reshape(bsz, n, nh, hp)
    return y.astype(x.dtype), h_final


def _mixer_a(px, pc, sink, ang, with_ctx):
    scale = HEAD_DIM ** -0.5
    grp = A_Q_HEADS // A_KV_HEADS
    nq, nkv = A_Q_HEADS * HEAD_DIM, A_KV_HEADS * HEAD_DIM

    def heads(p):
        bsz, n = p.shape[:2]
        q = p[..., :nq].reshape(bsz, n, A_KV_HEADS, grp, HEAD_DIM)
        k = p[..., nq:nq + nkv].reshape(bsz, n, A_KV_HEADS, HEAD_DIM)
        v = p[..., nq + nkv:].reshape(bsz, n, A_KV_HEADS, HEAD_DIM)
        return q, k, v

    qx, kx, vx = heads(px)
    qc, kc, vc = heads(pc)
    qx, kx = _rope_2d(qx, ang), _rope_2d(kx, ang)
    sink_kg = sink.reshape(A_KV_HEADS, grp)
    ox = _window_attend(qx, kx, vx, kc, vc, sink_kg, scale).reshape(px.shape[0], px.shape[1], MIX_A)
    oc = _attend(qc, kc, vc, scale, sink_kg).reshape(pc.shape[0], pc.shape[1], MIX_A) if with_ctx else None
    return ox, oc


def _mixer_b(px, pc, q_norm, k_norm, ang, with_ctx):
    scale = HEAD_DIM ** -0.5
    grp = B_Q_HEADS // B_KV_HEADS
    nq, nkv = B_Q_HEADS * HEAD_DIM, B_KV_HEADS * HEAD_DIM

    def heads(p):
        bsz, n = p.shape[:2]
        q = _rms(p[..., :nq].reshape(bsz, n, B_KV_HEADS, grp, HEAD_DIM), q_norm)
        k = _rms(p[..., nq:nq + nkv].reshape(bsz, n, B_KV_HEADS, HEAD_DIM), k_norm)
        v = p[..., nq + nkv:].reshape(bsz, n, B_KV_HEADS, HEAD_DIM)
        return q, k, v

    qx, kx, vx = heads(px)
    qc, kc, vc = heads(pc)
    qx, kx = _rope_2d(qx, ang), _rope_2d(kx, ang)
    k_all = jnp.concatenate([kx, kc], axis=1)
    v_all = jnp.concatenate([vx, vc], axis=1)
    ox = _attend_blocked(qx, k_all, v_all, scale).reshape(px.shape[0], px.shape[1], MIX_B)
    oc = _attend(qc, kc, vc, scale).reshape(pc.shape[0], pc.shape[1], MIX_B) if with_ctx else None
    return ox, oc


def _mixer_c(px, pc, q_norm, w_uq, kv_norm, w_ukv, ang, with_ctx):
    scale = (C_NOPE + C_ROPE) ** -0.5

    def proj(p, rope):
        bsz, n = p.shape[:2]
        cq = p[..., :C_Q_LORA]
        ckv = p[..., C_Q_LORA:C_Q_LORA + C_KV_LORA]
        k_rope = p[..., C_Q_LORA + C_KV_LORA:][:, :, None, :]
        q = (_rms(cq, q_norm) @ w_uq).reshape(bsz, n, C_HEADS, C_NOPE + C_ROPE)
        kv = (_rms(ckv, kv_norm) @ w_ukv).reshape(bsz, n, C_HEADS, C_NOPE + C_V)
        q_nope, q_rope = q[..., :C_NOPE], q[..., C_NOPE:]
        k_nope, v = kv[..., :C_NOPE], kv[..., C_NOPE:]
        if rope:
            q_rope, k_rope = _rope_2d(q_rope, ang), _rope_2d(k_rope, ang)
        q = jnp.concatenate([q_nope, q_rope], axis=-1)[:, :, :, None, :]
        k = jnp.concatenate([k_nope, jnp.broadcast_to(k_rope, k_nope.shape[:-1] + (C_ROPE,))], axis=-1)
        return q, k, v

    qx, kx, vx = proj(px, True)
    qc, kc, vc = proj(pc, False)
    k_all = jnp.concatenate([kx, kc], axis=1)
    v_all = jnp.concatenate([vx, vc], axis=1)
    ox = _attend_blocked(qx, k_all, v_all, scale).reshape(px.shape[0], px.shape[1], MIX_C)
    oc = _attend(qc, kc, vc, scale).reshape(pc.shape[0], pc.shape[1], MIX_C) if with_ctx else None
    return ox, oc


def _mixer_d(px, pc, conv_w, conv_b, a_log, dt_bias, d_skip, out_norm, with_ctx):
    a_neg = -jnp.exp(a_log.astype(jnp.float32))
    rep = D_HEADS // D_GROUPS
    gn = D_GROUPS * D_STATE

    def prep(p):
        bsz, n = p.shape[:2]
        z = p[..., :MIX_D]
        xbc = jax.nn.silu(_dwconv_centred(p[..., MIX_D:MIX_D + D_CONV_CH], conv_w, conv_b))
        xs = xbc[..., :MIX_D].reshape(bsz, n, D_HEADS, D_HEAD_DIM)
        bm = jnp.repeat(xbc[..., MIX_D:MIX_D + gn].reshape(bsz, n, D_GROUPS, D_STATE), rep, axis=2)
        cm = jnp.repeat(xbc[..., MIX_D + gn:].reshape(bsz, n, D_GROUPS, D_STATE), rep, axis=2)
        dt = jax.nn.softplus(p[..., MIX_D + D_CONV_CH:].astype(jnp.float32).reshape(bsz, n, 2, D_HEADS)
                             + dt_bias.astype(jnp.float32))
        return z, xs, bm, cm, dt

    def flip(t):
        return jnp.flip(t, axis=1)

    def scan_pair(xs, bm, cm, dt, h_f, h_b):
        y_f, s_f = _ssd(xs, dt[:, :, 0], a_neg[0], bm, cm, h_f)
        y_b, s_b = _ssd(flip(xs), flip(dt[:, :, 1]), a_neg[1], flip(bm), flip(cm), h_b)
        return y_f + flip(y_b), s_f, s_b

    def finish(y, xs, z):
        bsz, n = z.shape[:2]
        y = (y + d_skip[:, None] * xs).reshape(bsz, n, MIX_D)
        return _rms(y * jax.nn.silu(z), out_norm)

    zc, xc, bc, cc, dtc = prep(pc)
    h0 = jnp.zeros((pc.shape[0], D_HEADS, D_HEAD_DIM, D_STATE), jnp.float32)
    yc, sc_f, sc_b = scan_pair(xc, bc, cc, dtc, h0, h0)
    zx, xx, bx, cx, dtx = prep(px)
    yx, _, _ = scan_pair(xx, bx, cx, dtx, sc_f, sc_b)
    ox = finish(yx, xx, zx)
    oc = finish(yc, xc, zc) if with_ctx else None
    return ox, oc


def setup_inputs(seed: int = 0) -> dict:
    key = jax.random.key(seed)
    ks = list(jax.random.split(key, 32))

    def nrm(shape, scale):
        return jax.random.normal(ks.pop(), shape, jnp.float32) * scale

    def gain(shape):
        return 1.0 + nrm(shape, 0.05)

    L, D = DEPTH, D_MODEL
    x = nrm((BATCH, SEQ, D), 1.0)
    c = nrm((BATCH, D), 1.0)
    ctx = nrm((BATCH, CTX_LEN, D), 1.0)
    c_ctx = nrm((D,), 1.0)
    ada_w = nrm((L, D, N_MOD * D), 0.5 * D ** -0.5)
    ada_b = nrm((L, N_MOD * D), 0.02)
    ffn1_norm = gain((L, D))
    ffn1_wi = nrm((L, D, 2 * FFN_DIM), D ** -0.5)
    ffn1_wo = nrm((L, FFN_DIM, D), FFN_DIM ** -0.5)
    mix_norm = gain((L, D))
    w_in = nrm((L, D, IN_WIDTH), D ** -0.5)
    w_out = nrm((L, MIX_WIDTH, D), MIX_WIDTH ** -0.5)
    a_sink = nrm((L, A_Q_HEADS), 0.5)
    b_q_norm = gain((L, HEAD_DIM))
    b_k_norm = gain((L, HEAD_DIM))
    c_q_norm = gain((L, C_Q_LORA))
    c_w_uq = nrm((L, C_Q_LORA, C_HEADS * (C_NOPE + C_ROPE)), C_Q_LORA ** -0.5)
    c_kv_norm = gain((L, C_KV_LORA))
    c_w_ukv = nrm((L, C_KV_LORA, C_HEADS * (C_NOPE + C_V)), C_KV_LORA ** -0.5)
    d_conv_w = nrm((L, D_CONV, D_CONV_CH), D_CONV ** -0.5)
    d_conv_b = nrm((L, D_CONV_CH), 0.02)
    dt0 = jnp.exp(jax.random.uniform(ks.pop(), (L, 2, D_HEADS), jnp.float32,
                                     minval=math.log(1e-3), maxval=math.log(1e-1)))
    d_dt_bias = dt0 + jnp.log(-jnp.expm1(-dt0))
    d_a_log = jnp.log(jax.random.uniform(ks.pop(), (L, 2, D_HEADS), jnp.float32, minval=1.0, maxval=16.0))
    d_skip = gain((L, D_HEADS))
    d_out_norm = gain((L, MIX_D))
    ffn2_norm = gain((L, D))
    ffn2_wi = nrm((L, D, 2 * FFN_DIM), D ** -0.5)
    ffn2_wo = nrm((L, FFN_DIM, D), FFN_DIM ** -0.5)
    final_norm = gain((D,))
    return {"x": x, "c": c, "ctx": ctx, "c_ctx": c_ctx, "ada_w": ada_w, "ada_b": ada_b,
            "ffn1_norm": ffn1_norm, "ffn1_wi": ffn1_wi, "ffn1_wo": ffn1_wo,
            "mix_norm": mix_norm, "w_in": w_in, "w_out": w_out, "a_sink": a_sink,
            "b_q_norm": b_q_norm, "b_k_norm": b_k_norm, "c_q_norm": c_q_norm, "c_w_uq": c_w_uq,
            "c_kv_norm": c_kv_norm, "c_w_ukv": c_w_ukv, "d_conv_w": d_conv_w, "d_conv_b": d_conv_b,
            "d_a_log": d_a_log, "d_dt_bias": d_dt_bias, "d_skip": d_skip, "d_out_norm": d_out_norm,
            "ffn2_norm": ffn2_norm, "ffn2_wi": ffn2_wi, "ffn2_wo": ffn2_wo, "final_norm": final_norm}


def reference(x, c, ctx, c_ctx, ada_w, ada_b, ffn1_norm, ffn1_wi, ffn1_wo, mix_norm, w_in, w_out,
              a_sink, b_q_norm, b_k_norm, c_q_norm, c_w_uq, c_kv_norm, c_w_ukv, d_conv_w, d_conv_b,
              d_a_log, d_dt_bias, d_skip, d_out_norm, ffn2_norm, ffn2_wi, ffn2_wo, final_norm):
    hx, hc = x, ctx
    seq_len = x.shape[1]
    ang_head = _axial_angles(seq_len, HEAD_DIM)
    ang_mla = _axial_angles(seq_len, C_ROPE)
    cuts = [IN_A, IN_A + IN_B, IN_A + IN_B + IN_C]
    for l in range(DEPTH):
        with_ctx = l < DEPTH - 1
        mx = jnp.split((jax.nn.silu(c) @ ada_w[l] + ada_b[l])[:, None, :], N_MOD, axis=-1)
        mc = jnp.split((jax.nn.silu(c_ctx) @ ada_w[l] + ada_b[l])[None, None, :], N_MOD, axis=-1)
        hx = _ffn_half(hx, mx[0:3], ffn1_norm[l], ffn1_wi[l], ffn1_wo[l])
        hc = _ffn_half(hc, mc[0:3], ffn1_norm[l], ffn1_wi[l], ffn1_wo[l])
        px = _modulate(_rms(hx, mix_norm[l]), mx[3], mx[4]) @ w_in[l]
        pc = _modulate(_rms(hc, mix_norm[l]), mc[3], mc[4]) @ w_in[l]
        pxa, pxb, pxc, pxd = jnp.split(px, cuts, axis=-1)
        pca, pcb, pcc, pcd = jnp.split(pc, cuts, axis=-1)
        oxa, oca = _mixer_a(pxa, pca, a_sink[l], ang_head, with_ctx)
        oxb, ocb = _mixer_b(pxb, pcb, b_q_norm[l], b_k_norm[l], ang_head, with_ctx)
        oxc, occ = _mixer_c(pxc, pcc, c_q_norm[l], c_w_uq[l], c_kv_norm[l], c_w_ukv[l], ang_mla, with_ctx)
        oxd, ocd = _mixer_d(pxd, pcd, d_conv_w[l], d_conv_b[l], d_a_log[l], d_dt_bias[l], d_skip[l],
                            d_out_norm[l], with_ctx)
        hx = hx + mx[5] * (jnp.concatenate([oxa, oxb, oxc, oxd], axis=-1) @ w_out[l])
        hx = _ffn_half(hx, mx[6:9], ffn2_norm[l], ffn2_wi[l], ffn2_wo[l])
        if with_ctx:
            hc = hc + mc[5] * (jnp.concatenate([oca, ocb, occ, ocd], axis=-1) @ w_out[l])
            hc = _ffn_half(hc, mc[6:9], ffn2_norm[l], ffn2_wi[l], ffn2_wo[l])
    return _rms(hx, final_norm)
```

```cpp
#include <hip/hip_runtime.h>
#include <hip/hip_cooperative_groups.h>
#include <cstdio>
namespace cg = cooperative_groups;

#ifndef MULTI_LAUNCH
#define MULTI_LAUNCH 0
#endif

#define DI __device__ __forceinline__
typedef unsigned short bfu;
typedef __attribute__((ext_vector_type(8))) short bf16x8;
typedef __attribute__((ext_vector_type(4))) short bf16x4;
typedef __attribute__((ext_vector_type(16))) float f32x16;
typedef __attribute__((ext_vector_type(2))) __bf16 bf2_t;
typedef __attribute__((ext_vector_type(2))) float f2_t;
typedef __attribute__((ext_vector_type(4))) unsigned u32x4;
typedef __attribute__((ext_vector_type(2))) unsigned u32x2;

#define MFMA(a, b, c) __builtin_amdgcn_mfma_f32_32x32x16_bf16((a), (b), (c), 0, 0, 0)

DI unsigned pack2(float a, float b) { f2_t v = {a, b}; return __builtin_bit_cast(unsigned, __builtin_convertvector(v, bf2_t)); }
DI bfu f2bf(float a) { return (bfu)(pack2(a, 0.f) & 0xffffu); }
DI float bf2f(bfu v) { return __uint_as_float(((unsigned)v) << 16); }
DI float bflo(unsigned u) { return __uint_as_float(u << 16); }
DI float bfhi(unsigned u) { return __uint_as_float(u & 0xffff0000u); }
DI int crow(int reg, int h) { return (reg & 3) + 8 * (reg >> 2) + 4 * h; }
DI float silu_f(float x) { return x / (1.f + __expf(-x)); }

constexpr int D = 1024, SEQ = 2048, CTX = 256, NB = 8, FFN = 2816;
constexpr int TL = NB * SEQ;
constexpr int TC = NB * CTX;
constexpr int T = TL + TC;
constexpr int SA = CTX + SEQ;
constexpr int NWIN = 2688;
constexpr int NMOD = 9 * D;
constexpr float EPS = 1e-6f;
constexpr int NCH = 18;

constexpr size_t al(size_t x) { return (x + 255) & ~(size_t)255; }
constexpr size_t E_WI = (size_t)2 * FFN * D, E_WO = (size_t)D * FFN, E_WIN = (size_t)NWIN * D, E_WOUT = (size_t)D * D;
constexpr size_t E_UQ = 512 * 256, E_UKV = 512 * 128;
constexpr size_t W_WI1 = 0, W_WO1 = W_WI1 + E_WI, W_WIN = W_WO1 + E_WO, W_WOUT = W_WIN + E_WIN, W_WI2 = W_WOUT + E_WOUT,
                 W_WO2 = W_WI2 + E_WI, W_UQ = W_WO2 + E_WO, W_UKV = W_UQ + E_UQ, W_END = W_UKV + E_UKV;
constexpr size_t OFF_W = 0;
constexpr size_t OFF_MODS = al(OFF_W + W_END * 2);
constexpr size_t OFF_HC = al(OFF_MODS + (size_t)9 * NMOD * 4);
constexpr size_t OFF_NBUF = al(OFF_HC + (size_t)TC * D * 4);
constexpr size_t OFF_ROWSS = al(OFF_NBUF + (size_t)T * D * 2);
constexpr size_t OFF_MIX = al(OFF_ROWSS + (size_t)T * 4);
constexpr size_t OFF_ACT = OFF_MIX;
constexpr size_t SZ_Q = (size_t)NB * 4 * SA * 64 * 2, SZ_KV = (size_t)NB * 2 * SA * 64 * 2;
constexpr size_t OFF_QA = OFF_MIX, OFF_KA = al(OFF_QA + SZ_Q), OFF_VTA = al(OFF_KA + SZ_KV);
constexpr size_t OFF_QB = al(OFF_VTA + SZ_KV), OFF_KB = al(OFF_QB + SZ_Q), OFF_VTB = al(OFF_KB + SZ_KV);
constexpr size_t OFF_CQ = al(OFF_VTB + SZ_KV), OFF_CKV = al(OFF_CQ + (size_t)T * 256 * 2);
constexpr size_t OFF_QC = al(OFF_CKV + (size_t)T * 128 * 2), OFF_KC = al(OFF_QC + (size_t)NB * 4 * SA * 96 * 2);
constexpr size_t OFF_VTC = al(OFF_KC + (size_t)NB * 4 * SA * 96 * 2);
constexpr size_t OFF_Z = al(OFF_VTC + (size_t)NB * 4 * 64 * SA * 2), OFF_XBC = al(OFF_Z + (size_t)T * 256 * 2);
constexpr size_t OFF_DT = al(OFF_XBC + (size_t)T * 768 * 2), OFF_CS = al(OFF_DT + (size_t)T * 8 * 4);
constexpr size_t OFF_XT = al(OFF_CS + (size_t)T * 8 * 4), OFF_BM = al(OFF_XT + (size_t)NB * 4 * 64 * SA * 2);
constexpr size_t OFF_BT = al(OFF_BM + (size_t)NB * 2 * SA * 128 * 2), OFF_CM = al(OFF_BT + (size_t)NB * 2 * SA * 128 * 2);
constexpr size_t OFF_ST = al(OFF_CM + (size_t)NB * 2 * SA * 128 * 2);
constexpr size_t OFF_END = al(OFF_ST + (size_t)NB * 2 * NCH * 4 * 8192 * 2);
static_assert(OFF_ACT + (size_t)T * FFN * 2 <= OFF_END, "act alias fits");

constexpr int LDS_BYTES = 75776;

struct Params {
  const float* in[29];
  float* out;
  unsigned char* ws;
  int ph_lo, ph_hi;
};
enum { I_X = 0, I_C, I_CTX, I_CCTX, I_ADAW, I_ADAB, I_F1N, I_F1WI, I_F1WO, I_MIXN, I_WIN, I_WOUT, I_SINK, I_BQN, I_BKN, I_CQN, I_CWUQ,
       I_CKVN, I_CWUKV, I_CONVW, I_CONVB, I_ALOG, I_DTB, I_SKIP, I_ONORM, I_F2N, I_F2WI, I_F2WO, I_FINAL };

DI int row_b(int row) { return row < TL ? row / SEQ : (row - TL) / CTX; }
DI int row_pos(int row) { return row < TL ? CTX + row % SEQ : (row - TL) % CTX; }
DI int row_mrow(int row) { return row < TL ? row / SEQ : 8; }

DI int wmap(int wid, int n) {
  if (wid == 0) {
    int bn = n >> 7, wn = (n >> 6) & 1, nt = (n >> 5) & 1, c = n & 31;
    return nt * FFN + bn * 64 + wn * 32 + c;
  } else if (wid == 2) {
    if (n < 1024) return n;
    if (n < 1536) { int c = n - 1024; return c < 416 ? 1024 + c : -1; }
    int c = n - 1536; return c < 1032 ? 1440 + c : -1;
  } else if (wid == 4) {
    int hd = n >> 7, c = n & 127; return c < 96 ? hd * 96 + c : -1;
  }
  return n;
}

DI void conv_weight_tile(const float* __restrict__ W, int K, int N, bfu* __restrict__ Wt, int n0, int k0, int wid,
                         const float* __restrict__ ksc, int ksc_lo, float* sT) {
  const int tid = threadIdx.x;
#pragma unroll 4
  for (int i = 0; i < 16; ++i) {
    int idx = tid + 256 * i, kk = idx >> 6, nn = idx & 63;
    int col = wmap(wid, n0 + nn);
    float v = col >= 0 ? W[(size_t)(k0 + kk) * N + col] : 0.f;
    if (ksc && (k0 + kk) >= ksc_lo) v *= ksc[k0 + kk - ksc_lo];
    sT[nn * 65 + kk] = v;
  }
  __syncthreads();
#pragma unroll
  for (int i = 0; i < 2; ++i) {
    int idx = tid + 256 * i, nn = idx >> 3, kc = idx & 7;
    const float* s = sT + nn * 65 + kc * 8;
    u32x4 o; o[0] = pack2(s[0], s[1]); o[1] = pack2(s[2], s[3]); o[2] = pack2(s[4], s[5]); o[3] = pack2(s[6], s[7]);
    *(u32x4*)(Wt + (size_t)(n0 + nn) * K + k0 + kc * 8) = o;
  }
  __syncthreads();
}

DI void phase_convert(const Params& P, int l, char* lds) {
  float* sT = (float*)lds;
  bfu* Wb = (bfu*)(P.ws + OFF_W);
  const int t_wi = 88 * 16, t_wo = 16 * 44, t_win = 42 * 16, t_wout = 16 * 16, t_uq = 8 * 4, t_ukv = 8 * 2;
  const int c0 = t_wi, c1 = c0 + t_wo, c2 = c1 + t_win, c3 = c2 + t_wout, c4 = c3 + t_wi, c5 = c4 + t_wo, c6 = c5 + t_uq, c7 = c6 + t_ukv;
  const int n_mod = 288;
  const int total = c7 + n_mod;
  for (int it = blockIdx.x; it < total; it += gridDim.x) {
    if (it < c7) {
      const float* W; int K, N, wid, id; bfu* Wt; const float* ksc = nullptr; int ksc_lo = 0; int nkt;
      if (it < c0)      { id = it;      W = P.in[I_F1WI] + (size_t)l * D * 2 * FFN; K = D; N = 2 * FFN; wid = 0; Wt = Wb + W_WI1; }
      else if (it < c1) { id = it - c0; W = P.in[I_F1WO] + (size_t)l * FFN * D; K = FFN; N = D; wid = 1; Wt = Wb + W_WO1; }
      else if (it < c2) { id = it - c1; W = P.in[I_WIN] + (size_t)l * D * 2472; K = D; N = 2472; wid = 2; Wt = Wb + W_WIN; }
      else if (it < c3) { id = it - c2; W = P.in[I_WOUT] + (size_t)l * D * D; K = D; N = D; wid = 3; Wt = Wb + W_WOUT; ksc = P.in[I_ONORM] + l * 256; ksc_lo = 768; }
      else if (it < c4) { id = it - c3; W = P.in[I_F2WI] + (size_t)l * D * 2 * FFN; K = D; N = 2 * FFN; wid = 0; Wt = Wb + W_WI2; }
      else if (it < c5) { id = it - c4; W = P.in[I_F2WO] + (size_t)l * FFN * D; K = FFN; N = D; wid = 1; Wt = Wb + W_WO2; }
      else if (it < c6) { id = it - c5; W = P.in[I_CWUQ] + (size_t)l * 256 * 384; K = 256; N = 384; wid = 4; Wt = Wb + W_UQ; ksc = P.in[I_CQN] + l * 256; }
      else              { id = it - c6; W = P.in[I_CWUKV] + (size_t)l * 128 * 512; K = 128; N = 512; wid = 5; Wt = Wb + W_UKV; ksc = P.in[I_CKVN] + l * 128; }
      nkt = K / 64;
      conv_weight_tile(W, K, N, Wt, (id / nkt) * 64, (id % nkt) * 64, wid, ksc, ksc_lo, sT);
    } else {
      const int id = it - c7, tid = threadIdx.x;
      float* sS = sT;
      float* sR = sT + 9 * 1024;
      for (int i = tid; i < 9 * 1024; i += 256) {
        int rr = i >> 10, k = i & 1023;
        float cv = rr < 8 ? P.in[I_C][rr * 1024 + k] : P.in[I_CCTX][k];
        sS[i] = silu_f(cv);
      }
      __syncthreads();
      const int col = id * 32 + (tid & 31), kq = tid >> 5;
      const float* W = P.in[I_ADAW] + (size_t)l * D * NMOD + col;
      float acc[9];
#pragma unroll
      for (int j = 0; j < 9; ++j) acc[j] = 0.f;
      for (int k = kq * 128; k < kq * 128 + 128; ++k) {
        float w = W[(size_t)k * NMOD];
#pragma unroll
        for (int j = 0; j < 9; ++j) acc[j] += sS[j * 1024 + k] * w;
      }
#pragma unroll
      for (int j = 0; j < 9; ++j) sR[(kq * 9 + j) * 32 + (tid & 31)] = acc[j];
      __syncthreads();
      for (int i = tid; i < 9 * 32; i += 256) {
        int j = i >> 5, cc = i & 31;
        float s = 0.f;
#pragma unroll
        for (int q = 0; q < 8; ++q) s += sR[(q * 9 + j) * 32 + cc];
        int c2_ = id * 32 + cc;
        ((float*)(P.ws + OFF_MODS))[j * NMOD + c2_] = s + P.in[I_ADAB][l * NMOD + c2_];
      }
      __syncthreads();
    }
  }
}

DI void phase_norm(const Params& P, const float* src_lat, const float* src_ctx, const float* g, int shift_idx, int scale_idx, int M, bool zero_rowss) {
  const int lane = threadIdx.x & 63, wave = threadIdx.x >> 6;
  const float* mods = (const float*)(P.ws + OFF_MODS);
  bfu* dst = (bfu*)(P.ws + OFF_NBUF);
  float* rowss = (float*)(P.ws + OFF_ROWSS);
  for (int row = blockIdx.x * 4 + wave; row < M; row += gridDim.x * 4) {
    const float* src = row < TL ? src_lat + (size_t)row * D : src_ctx + (size_t)(row - TL) * D;
    float4 v[4]; float ss = 0.f;
#pragma unroll
    for (int i = 0; i < 4; ++i) { v[i] = ((const float4*)src)[lane + 64 * i]; ss += v[i].x * v[i].x + v[i].y * v[i].y + v[i].z * v[i].z + v[i].w * v[i].w; }
#pragma unroll
    for (int o = 32; o >= 1; o >>= 1) ss += __shfl_xor(ss, o);
    const float r = rsqrtf(ss * (1.f / D) + EPS);
    const float* msh = mods + row_mrow(row) * NMOD + shift_idx * D;
    const float* msc = mods + row_mrow(row) * NMOD + scale_idx * D;
#pragma unroll
    for (int i = 0; i < 4; ++i) {
      const int c = (lane + 64 * i) * 4;
      float4 gg = *(const float4*)(g + c), sh = *(const float4*)(msh + c), sc = *(const float4*)(msc + c);
      float a0 = v[i].x * r * gg.x * (1.f + sc.x) + sh.x, a1 = v[i].y * r * gg.y * (1.f + sc.y) + sh.y;
      float a2 = v[i].z * r * gg.z * (1.f + sc.z) + sh.z, a3 = v[i].w * r * gg.w * (1.f + sc.w) + sh.w;
      u32x2 o; o[0] = pack2(a0, a1); o[1] = pack2(a2, a3);
      *(u32x2*)(dst + (size_t)row * D + c) = o;
    }
    if (zero_rowss && lane == 0) rowss[row] = 0.f;
  }
}

DI void phase_final(const Params& P) {
  const int lane = threadIdx.x & 63, wave = threadIdx.x >> 6;
  const float* g = P.in[I_FINAL];
  for (int row = blockIdx.x * 4 + wave; row < TL; row += gridDim.x * 4) {
    float* src = P.out + (size_t)row * D;
    float4 v[4]; float ss = 0.f;
#pragma unroll
    for (int i = 0; i < 4; ++i) { v[i] = ((const float4*)src)[lane + 64 * i]; ss += v[i].x * v[i].x + v[i].y * v[i].y + v[i].z * v[i].z + v[i].w * v[i].w; }
#pragma unroll
    for (int o = 32; o >= 1; o >>= 1) ss += __shfl_xor(ss, o);
    const float r = rsqrtf(ss * (1.f / D) + EPS);
#pragma unroll
    for (int i = 0; i < 4; ++i) {
      const int c = (lane + 64 * i) * 4;
      float4 gg = *(const float4*)(g + c);
      float4 o = {v[i].x * r * gg.x, v[i].y * r * gg.y, v[i].z * r * gg.z, v[i].w * r * gg.w};
      ((float4*)src)[lane + 64 * i] = o;
    }
  }
}

constexpr int LDSS = 72;
constexpr int TILE_E = 128 * LDSS;

DI void gemm_mainloop(const bfu* __restrict__ A, int lda, const bfu* __restrict__ W, int K, int bm, int bn, int kshift,
                      const float* rowss, char* lds, f32x16 (&acc)[2][2]) {
  bfu* sA = (bfu*)lds;
  bfu* sB = sA + 2 * TILE_E;
  const int tid = threadIdx.x, lane = tid & 63, wave = tid >> 6, r = lane & 31, h = lane >> 5;
  const int wm = wave >> 1, wn = wave & 1;
  const int nk = K / 64;
#pragma unroll
  for (int a = 0; a < 2; ++a)
#pragma unroll
    for (int b = 0; b < 2; ++b)
#pragma unroll
      for (int i = 0; i < 16; ++i) acc[a][b][i] = 0.f;
  const bfu* Ag = A + (size_t)(bm * 128 + (tid >> 3)) * lda + (tid & 7) * 8;
  const bfu* Wg = W + (size_t)(bn * 128 + (tid >> 3)) * K + (tid & 7) * 8;
  const int soff = (tid >> 3) * LDSS + (tid & 7) * 8;
  u32x4 ra[4], rb[4];
  {
    const int k0 = ((0 + kshift) % nk) * 64;
#pragma unroll
    for (int i = 0; i < 4; ++i) { ra[i] = *(const u32x4*)(Ag + (size_t)(32 * i) * lda + k0); rb[i] = *(const u32x4*)(Wg + (size_t)(32 * i) * K + k0); }
#pragma unroll
    for (int i = 0; i < 4; ++i) { *(u32x4*)(sA + soff + 32 * i * LDSS) = ra[i]; *(u32x4*)(sB + soff + 32 * i * LDSS) = rb[i]; }
  }
  __syncthreads();
  for (int kt = 0; kt < nk; ++kt) {
    const int cur = kt & 1;
    if (kt + 1 < nk) {
      const int k0 = ((kt + 1 + kshift) % nk) * 64;
#pragma unroll
      for (int i = 0; i < 4; ++i) { ra[i] = *(const u32x4*)(Ag + (size_t)(32 * i) * lda + k0); rb[i] = *(const u32x4*)(Wg + (size_t)(32 * i) * K + k0); }
    }
    const bfu* cA = sA + cur * TILE_E + (wm * 64 + r) * LDSS + h * 8;
    const bfu* cB = sB + cur * TILE_E + (wn * 64 + r) * LDSS + h * 8;
#pragma unroll
    for (int s = 0; s < 4; ++s) {
      bf16x8 a0 = *(const bf16x8*)(cA + s * 16), a1 = *(const bf16x8*)(cA + 32 * LDSS + s * 16);
      bf16x8 b0 = *(const bf16x8*)(cB + s * 16), b1 = *(const bf16x8*)(cB + 32 * LDSS + s * 16);
      acc[0][0] = MFMA(a0, b0, acc[0][0]); acc[0][1] = MFMA(a0, b1, acc[0][1]);
      acc[1][0] = MFMA(a1, b0, acc[1][0]); acc[1][1] = MFMA(a1, b1, acc[1][1]);
    }
    if (rowss != nullptr && kt == 3) {
#pragma unroll
      for (int mt = 0; mt < 2; ++mt)
#pragma unroll
        for (int i = 0; i < 16; ++i) {
          const int row = bm * 128 + wm * 64 + mt * 32 + crow(i, h);
          const float rs = rsqrtf(rowss[row] * (1.f / 256.f) + EPS);
          acc[mt][0][i] *= rs; acc[mt][1][i] *= rs;
        }
    }
    if (kt + 1 < nk) {
      bfu* dA = sA + (cur ^ 1) * TILE_E + soff; bfu* dB = sB + (cur ^ 1) * TILE_E + soff;
#pragma unroll
      for (int i = 0; i < 4; ++i) { *(u32x4*)(dA + 32 * i * LDSS) = ra[i]; *(u32x4*)(dB + 32 * i * LDSS) = rb[i]; }
    }
    __syncthreads();
  }
}

DI void tile_coords(int id, int NT, int& bm, int& bn) { const int per = 16 * NT; const int sg = id / per, rem = id % per; bm = sg * 16 + (rem & 15); bn = rem >> 4; }

constexpr int SCS = 129;
DI void stage_acc(float* sC, const f32x16 (&acc)[2][2]) {
  const int lane = threadIdx.x & 63, wave = threadIdx.x >> 6, r = lane & 31, h = lane >> 5, wm = wave >> 1, wn = wave & 1;
#pragma unroll
  for (int mt = 0; mt < 2; ++mt)
#pragma unroll
    for (int nt = 0; nt < 2; ++nt)
#pragma unroll
      for (int i = 0; i < 16; ++i) sC[(wm * 64 + mt * 32 + crow(i, h)) * SCS + wn * 64 + nt * 32 + r] = acc[mt][nt][i];
}

DI void phase_gemm_swiglu(const Params& P, const bfu* Wt, int M, char* lds) {
  const bfu* A = (const bfu*)(P.ws + OFF_NBUF);
  bfu* act = (bfu*)(P.ws + OFF_ACT);
  const int NT = 44, ntiles = (M / 128) * NT;
  const int lane = threadIdx.x & 63, wave = threadIdx.x >> 6, r = lane & 31, h = lane >> 5, wm = wave >> 1, wn = wave & 1;
  for (int t = blockIdx.x; t < ntiles; t += gridDim.x) {
    int bm, bn; tile_coords(t, NT, bm, bn);
    f32x16 acc[2][2];
    gemm_mainloop(A, D, Wt, D, bm, bn, 0, nullptr, lds, acc);
#pragma unroll
    for (int mt = 0; mt < 2; ++mt)
#pragma unroll
      for (int i = 0; i < 16; ++i) {
        const int row = bm * 128 + wm * 64 + mt * 32 + crow(i, h);
        const float a = acc[mt][0][i], b = acc[mt][1][i];
        act[(size_t)row * FFN + bn * 64 + wn * 32 + r] = f2bf(silu_f(a) * b);
      }
  }
}

DI void phase_gemm_resid(const Params& P, const bfu* A, int K, const bfu* Wt, int M, int gidx, float gs,
                         const float* src_lat, const float* src_ctx, int kshift, const float* rowss, char* lds) {
  const float* mods = (const float*)(P.ws + OFF_MODS);
  float* dst_lat = P.out; float* dst_ctx = (float*)(P.ws + OFF_HC);
  const int NT = 8, ntiles = (M / 128) * NT;
  const int lane = threadIdx.x & 63, wave = threadIdx.x >> 6, r = lane & 31, h = lane >> 5, wm = wave >> 1, wn = wave & 1;
  for (int t = blockIdx.x; t < ntiles; t += gridDim.x) {
    int bm, bn; tile_coords(t, NT, bm, bn);
    f32x16 acc[2][2];
    gemm_mainloop(A, K, Wt, K, bm, bn, kshift, rowss, lds, acc);
    const int row0 = bm * 128;
    const float* gate = mods + row_mrow(row0) * NMOD + gidx * D;
    const bool lat = row0 < TL;
#pragma unroll
    for (int mt = 0; mt < 2; ++mt)
#pragma unroll
      for (int nt = 0; nt < 2; ++nt)
#pragma unroll
        for (int i = 0; i < 16; ++i) {
          const int row = row0 + wm * 64 + mt * 32 + crow(i, h);
          const int col = bn * 128 + wn * 64 + nt * 32 + r;
          const size_t off = lat ? (size_t)row * D + col : (size_t)(row - TL) * D + col;
          const float s = lat ? src_lat[off] : src_ctx[off];
          const float v = s + gs * gate[col] * acc[mt][nt][i];
          if (lat) dst_lat[off] = v; else dst_ctx[off] = v;
        }
  }
}

template <int NF>
DI void rope2d(float* v, int t) {
  const float ri = (float)(t >> 6), ci = (float)(t & 63);
#pragma unroll
  for (int d = 0; d < NF; ++d) {
    const float inv = exp2f(-(float)d * (13.287712379549449f / NF));
    float ar = ri * inv, ac = ci * inv;
    float cr = __cosf(ar), sr = __sinf(ar), cc = __cosf(ac), sc = __sinf(ac);
    float x1 = v[d], x2 = v[NF + d];
    v[d] = x1 * cr - x2 * sr; v[NF + d] = x2 * cr + x1 * sr;
    float y1 = v[2 * NF + d], y2 = v[3 * NF + d];
    v[2 * NF + d] = y1 * cc - y2 * sc; v[3 * NF + d] = y2 * cc + y1 * sc;
  }
}

DI void store_row_bf16_64(bfu* dst, const float* v) {
#pragma unroll
  for (int c = 0; c < 8; ++c) {
    u32x4 o; o[0] = pack2(v[c * 8], v[c * 8 + 1]); o[1] = pack2(v[c * 8 + 2], v[c * 8 + 3]); o[2] = pack2(v[c * 8 + 4], v[c * 8 + 5]); o[3] = pack2(v[c * 8 + 6], v[c * 8 + 7]);
    *(u32x4*)(dst + c * 8) = o;
  }
}

DI void write_raw_rows(const float* sC, bfu* dst, int pitch, int col0, int grow0) {
  const int tid = threadIdx.x, rr = tid & 127, half = tid >> 7;
  float v[64];
#pragma unroll
  for (int j = 0; j < 64; ++j) v[j] = sC[rr * SCS + half * 64 + j];
  store_row_bf16_64(dst + (size_t)(grow0 + rr) * pitch + col0 + half * 64, v);
}

DI void write_col_T(const float* sC, int col, int half, bfu* dstT, float sc0, const float* rscale) {
#pragma unroll
  for (int c = 0; c < 8; ++c) {
    float v[8];
#pragma unroll
    for (int j = 0; j < 8; ++j) { const int rr = half * 64 + c * 8 + j; v[j] = sC[rr * SCS + col] * (rscale ? rscale[rr] : sc0); }
    u32x4 o; o[0] = pack2(v[0], v[1]); o[1] = pack2(v[2], v[3]); o[2] = pack2(v[4], v[5]); o[3] = pack2(v[6], v[7]);
    *(u32x4*)(dstT + half * 64 + c * 8) = o;
  }
}

DI void phase_gemm_win(const Params& P, int l, char* lds) {
  const bfu* A = (const bfu*)(P.ws + OFF_NBUF);
  const bfu* Wt = (const bfu*)(P.ws + OFF_W) + W_WIN;
  float* sC = (float*)lds;
  const int NT = 21, ntiles = 144 * NT;
  const int tid = threadIdx.x;
  for (int t = blockIdx.x; t < ntiles; t += gridDim.x) {
    int bm, bn; tile_coords(t, NT, bm, bn);
    f32x16 acc[2][2];
    gemm_mainloop(A, D, Wt, D, bm, bn, 0, nullptr, lds, acc);
    stage_acc(sC, acc);
    __syncthreads();
    const int grow0 = bm * 128;
    const bool lat = grow0 < TL;
    const int b = row_b(grow0), pos0 = row_pos(grow0);
    if (bn < 8) {
      const int mixer = bn >> 2, sub = bn & 3;
      if (sub < 3) {
        const int rr = tid & 127, hh = tid >> 7;
        float v[64];
#pragma unroll
        for (int j = 0; j < 64; ++j) v[j] = sC[rr * SCS + hh * 64 + j];
        if (mixer == 1) {
          float ss = 0.f;
#pragma unroll
          for (int j = 0; j < 64; ++j) ss += v[j] * v[j];
          const float rn = rsqrtf(ss * (1.f / 64.f) + EPS);
          const float* gn = (sub < 2 ? P.in[I_BQN] : P.in[I_BKN]) + l * 64;
#pragma unroll
          for (int j = 0; j < 64; ++j) v[j] = v[j] * rn * gn[j];
        }
        if (lat) rope2d<16>(v, pos0 + rr - CTX);
        bfu* dst;
        if (sub < 2) {
#pragma unroll
          for (int j = 0; j < 64; ++j) v[j] *= 0.125f;
          const int hq = sub * 2 + hh;
          dst = (bfu*)(P.ws + (mixer ? OFF_QB : OFF_QA)) + ((size_t)(b * 4 + hq) * SA + pos0 + rr) * 64;
        } else {
          dst = (bfu*)(P.ws + (mixer ? OFF_KB : OFF_KA)) + ((size_t)(b * 2 + hh) * SA + pos0 + rr) * 64;
        }
        store_row_bf16_64(dst, v);
      } else {
        const int col = tid & 127, half = tid >> 7, kvh = col >> 6, d = col & 63;
        bfu* dstT = (bfu*)(P.ws + (mixer ? OFF_VTB : OFF_VTA)) + ((size_t)(b * 2 + kvh) * 64 + d) * SA + pos0;
        write_col_T(sC, col, half, dstT, 1.f, nullptr);
      }
    } else if (bn < 12) {
      if (bn < 10) write_raw_rows(sC, (bfu*)(P.ws + OFF_CQ), 256, (bn - 8) * 128, grow0);
      else if (bn == 10) write_raw_rows(sC, (bfu*)(P.ws + OFF_CKV), 128, 0, grow0);
      else if (tid < 128) {
        const int rr = tid;
        float v[32];
#pragma unroll
        for (int j = 0; j < 32; ++j) v[j] = sC[rr * SCS + j];
        if (lat) rope2d<8>(v, pos0 + rr - CTX);
        u32x4 o[4];
#pragma unroll
        for (int c = 0; c < 4; ++c) { o[c][0] = pack2(v[c * 8], v[c * 8 + 1]); o[c][1] = pack2(v[c * 8 + 2], v[c * 8 + 3]); o[c][2] = pack2(v[c * 8 + 4], v[c * 8 + 5]); o[c][3] = pack2(v[c * 8 + 6], v[c * 8 + 7]); }
#pragma unroll
        for (int hd = 0; hd < 4; ++hd) {
          bfu* dst = (bfu*)(P.ws + OFF_KC) + ((size_t)(b * 4 + hd) * SA + pos0 + rr) * 96 + 64;
#pragma unroll
          for (int c = 0; c < 4; ++c) *(u32x4*)(dst + c * 8) = o[c];
        }
      }
    } else {
      if (bn < 14) write_raw_rows(sC, (bfu*)(P.ws + OFF_Z), 256, (bn - 12) * 128, grow0);
      else if (bn < 20) write_raw_rows(sC, (bfu*)(P.ws + OFF_XBC), 768, (bn - 14) * 128, grow0);
      else if (tid < 8) {
        const int j = tid;
        const float bias = P.in[I_DTB][l * 8 + j];
        const float a_neg = -__expf(P.in[I_ALOG][l * 8 + j]);
        float* DT = (float*)(P.ws + OFF_DT); float* CS = (float*)(P.ws + OFF_CS);
        float run = 0.f;
        for (int rr = 0; rr < 128; ++rr) {
          const float x = sC[rr * SCS + j] + bias;
          const float dt = fmaxf(x, 0.f) + log1pf(__expf(-fabsf(x)));
          run += dt * a_neg;
          DT[(size_t)(grow0 + rr) * 8 + j] = dt; CS[(size_t)(grow0 + rr) * 8 + j] = run;
        }
      }
    }
    __syncthreads();
  }
}

DI void mla_uq_tile(const Params& P, int bm, int hd, char* lds) {
  const bfu* A = (const bfu*)(P.ws + OFF_CQ);
  const bfu* Wt = (const bfu*)(P.ws + OFF_W) + W_UQ;
  float* sC = (float*)lds; float* sR = sC + 128 * SCS;
  const int tid = threadIdx.x;
  f32x16 acc[2][2];
  gemm_mainloop(A, 256, Wt, 256, bm, hd, 0, nullptr, lds, acc);
  stage_acc(sC, acc);
  const int grow0 = bm * 128;
  {
    const int rr = tid >> 1, part = tid & 1;
    const u32x4* src = (const u32x4*)(A + (size_t)(grow0 + rr) * 256 + part * 128);
    float ss = 0.f;
#pragma unroll
    for (int c = 0; c < 16; ++c) { u32x4 u = src[c];
#pragma unroll
      for (int j = 0; j < 4; ++j) { float a = bflo(u[j]), bb = bfhi(u[j]); ss += a * a + bb * bb; } }
    ss += __shfl_xor(ss, 1);
    if (part == 0) sR[rr] = rsqrtf(ss * (1.f / 256.f) + EPS);
  }
  __syncthreads();
  if (tid < 128) {
    const int rr = tid;
    const bool lat = grow0 < TL;
    const int b = row_b(grow0), pos = row_pos(grow0) + rr;
    const float rs = sR[rr];
    const float qs = rs * 0.10206207261596575f;
    bfu* dst = (bfu*)(P.ws + OFF_QC) + ((size_t)(b * 4 + hd) * SA + pos) * 96;
    float v[64];
#pragma unroll
    for (int j = 0; j < 64; ++j) v[j] = sC[rr * SCS + j] * qs;
    store_row_bf16_64(dst, v);
    float w[32];
#pragma unroll
    for (int j = 0; j < 32; ++j) w[j] = sC[rr * SCS + 64 + j] * qs;
    if (lat) rope2d<8>(w, pos - CTX);
#pragma unroll
    for (int c = 0; c < 4; ++c) {
      u32x4 o; o[0] = pack2(w[c * 8], w[c * 8 + 1]); o[1] = pack2(w[c * 8 + 2], w[c * 8 + 3]); o[2] = pack2(w[c * 8 + 4], w[c * 8 + 5]); o[3] = pack2(w[c * 8 + 6], w[c * 8 + 7]);
      *(u32x4*)(dst + 64 + c * 8) = o;
    }
  }
  __syncthreads();
}

DI void mla_ukv_tile(const Params& P, int bm, int hd, char* lds) {
  const bfu* A = (const bfu*)(P.ws + OFF_CKV);
  const bfu* Wt = (const bfu*)(P.ws + OFF_W) + W_UKV;
  float* sC = (float*)lds; float* sR = sC + 128 * SCS;
  const int tid = threadIdx.x;
  f32x16 acc[2][2];
  gemm_mainloop(A, 128, Wt, 128, bm, hd, 0, nullptr, lds, acc);
  stage_acc(sC, acc);
  const int grow0 = bm * 128;
  {
    const int rr = tid >> 1, part = tid & 1;
    const u32x4* src = (const u32x4*)(A + (size_t)(grow0 + rr) * 128 + part * 64);
    float ss = 0.f;
#pragma unroll
    for (int c = 0; c < 8; ++c) { u32x4 u = src[c];
#pragma unroll
      for (int j = 0; j < 4; ++j) { float a = bflo(u[j]), bb = bfhi(u[j]); ss += a * a + bb * bb; } }
    ss += __shfl_xor(ss, 1);
    if (part == 0) sR[rr] = rsqrtf(ss * (1.f / 128.f) + EPS);
  }
  __syncthreads();
  const int b = row_b(grow0), pos0 = row_pos(grow0);
  if (tid < 128) {
    const int rr = tid;
    const float rs = sR[rr];
    float v[64];
#pragma unroll
    for (int j = 0; j < 64; ++j) v[j] = sC[rr * SCS + j] * rs;
    store_row_bf16_64((bfu*)(P.ws + OFF_KC) + ((size_t)(b * 4 + hd) * SA + pos0 + rr) * 96, v);
  } else {
    const int q = tid - 128, d = q & 63, half = q >> 6;
    bfu* dstT = (bfu*)(P.ws + OFF_VTC) + ((size_t)(b * 4 + hd) * 64 + d) * SA + pos0;
    write_col_T(sC, 64 + d, half, dstT, 1.f, sR);
  }
  __syncthreads();
}

DI void conv_prep_tile(const Params& P, int l, int rt, int ct, char* lds) {
  float* sIn = (float*)lds;
  const int tid = threadIdx.x;
  const int grow0 = rt * 128;
  const bool lat = grow0 < TL;
  const int b = row_b(grow0), pos0 = row_pos(grow0);
  const int seg_lo = lat ? b * SEQ : TL + b * CTX, seg_hi = seg_lo + (lat ? SEQ : CTX);
  const bfu* X = (const bfu*)(P.ws + OFF_XBC);
  for (int idx = tid; idx < 132 * 16; idx += 256) {
    const int rr = idx >> 4, c8 = idx & 15;
    const int grow = grow0 - 2 + rr;
    u32x4 u = {0u, 0u, 0u, 0u};
    if (grow >= seg_lo && grow < seg_hi) u = *(const u32x4*)(X + (size_t)grow * 768 + ct * 128 + c8 * 8);
    float* d = sIn + rr * 128 + c8 * 8;
#pragma unroll
    for (int j = 0; j < 4; ++j) { d[2 * j] = bflo(u[j]); d[2 * j + 1] = bfhi(u[j]); }
  }
  __syncthreads();
  const int cc = tid & 127, half = tid >> 7, ch = ct * 128 + cc;
  float w[5];
#pragma unroll
  for (int k = 0; k < 5; ++k) w[k] = P.in[I_CONVW][(size_t)l * 5 * 768 + k * 768 + ch];
  const float bias = P.in[I_CONVB][l * 768 + ch];
  bfu* dT = nullptr; bfu* dR = nullptr;
  if (ct < 2) { const int hd = ct * 2 + (cc >> 6), p = cc & 63; dT = (bfu*)(P.ws + OFF_XT) + ((size_t)(b * 4 + hd) * 64 + p) * SA + pos0 + half * 64; }
  else if (ct < 4) { const int g = ct - 2; dT = (bfu*)(P.ws + OFF_BT) + ((size_t)(b * 2 + g) * 128 + cc) * SA + pos0 + half * 64;
                     dR = (bfu*)(P.ws + OFF_BM) + ((size_t)(b * 2 + g) * SA + pos0 + half * 64) * 128 + cc; }
  else { const int g = ct - 4; dR = (bfu*)(P.ws + OFF_CM) + ((size_t)(b * 2 + g) * SA + pos0 + half * 64) * 128 + cc; }
  for (int c = 0; c < 8; ++c) {
    float in[12];
#pragma unroll
    for (int j = 0; j < 12; ++j) in[j] = sIn[(half * 64 + c * 8 + j) * 128 + cc];
    float o[8];
#pragma unroll
    for (int j = 0; j < 8; ++j) {
      float s = bias;
#pragma unroll
      for (int k = 0; k < 5; ++k) s += w[k] * in[j + k];
      o[j] = silu_f(s);
    }
    if (dT) { u32x4 q; q[0] = pack2(o[0], o[1]); q[1] = pack2(o[2], o[3]); q[2] = pack2(o[4], o[5]); q[3] = pack2(o[6], o[7]); *(u32x4*)(dT + c * 8) = q; }
    if (dR) {
#pragma unroll
      for (int j = 0; j < 8; ++j) dR[(size_t)(c * 8 + j) * 128] = f2bf(o[j]);
    }
  }
  __syncthreads();
}

DI void phase_mla_conv(const Params& P, int l, char* lds) {
  const int n_uq = 144 * 4, n_ukv = 144 * 4, n_cv = 144 * 6;
  const int total = n_uq + n_ukv + n_cv;
  for (int it = blockIdx.x; it < total; it += gridDim.x) {
    if (it < n_uq) mla_uq_tile(P, it >> 2, it & 3, lds);
    else if (it < n_uq + n_ukv) { const int id = it - n_uq; mla_ukv_tile(P, id >> 2, id & 3, lds); }
    else { const int id = it - n_uq - n_ukv; conv_prep_tile(P, l, id / 6, id % 6, lds); }
  }
}

template <int DQK>
DI void attn_item(const bfu* __restrict__ Qp, const bfu* __restrict__ Kp, const bfu* __restrict__ VTp, int n1, int p1, int n2, int p2,
                  bool masked, int q0lat, bool has_sink, float sink, bfu* __restrict__ Op, char* lds) {
  constexpr int KS = DQK + 8, NKS = DQK / 16, VS = 72;
  bfu* sK = (bfu*)lds;
  bfu* sV = sK + 64 * KS;
  const int tid = threadIdx.x, lane = tid & 63, wave = tid >> 6, r = lane & 31, h = lane >> 5;
  bf16x8 qf[NKS];
  const bfu* qrow = Qp + (size_t)(wave * 32 + r) * DQK;
#pragma unroll
  for (int s = 0; s < NKS; ++s) qf[s] = *(const bf16x8*)(qrow + s * 16 + h * 8);
  f32x16 o[2];
#pragma unroll
  for (int i = 0; i < 16; ++i) { o[0][i] = 0.f; o[1][i] = 0.f; }
  float m = has_sink ? sink : -INFINITY;
  float lsum = (has_sink && h == 0) ? 1.f : 0.f;
  const int qpos = q0lat + wave * 32 + r;
  const int nt = n1 + n2;
  for (int tt = 0; tt < nt; ++tt) {
    const int pos = tt < n1 ? p1 + tt * 64 : p2 + (tt - n1) * 64;
    __syncthreads();
    for (int c = tid; c < 64 * (DQK / 8); c += 256) {
      const int kr = c / (DQK / 8), kc = c % (DQK / 8);
      *(u32x4*)(sK + kr * KS + kc * 8) = *(const u32x4*)(Kp + (size_t)(pos + kr) * DQK + kc * 8);
    }
    for (int c = tid; c < 512; c += 256) {
      const int d = c >> 3, kc = c & 7;
      *(u32x4*)(sV + d * VS + kc * 8) = *(const u32x4*)(VTp + (size_t)d * SA + pos + kc * 8);
    }
    __syncthreads();
    f32x16 s[2];
#pragma unroll
    for (int i = 0; i < 16; ++i) { s[0][i] = 0.f; s[1][i] = 0.f; }
#pragma unroll
    for (int mt = 0; mt < 2; ++mt)
#pragma unroll
      for (int ks = 0; ks < NKS; ++ks) {
        bf16x8 a = *(const bf16x8*)(sK + (mt * 32 + r) * KS + ks * 16 + h * 8);
        s[mt] = MFMA(a, qf[ks], s[mt]);
      }
    if (masked && tt >= n1) {
      const int kbase = pos - CTX;
#pragma unroll
      for (int mt = 0; mt < 2; ++mt)
#pragma unroll
        for (int i = 0; i < 16; ++i) {
          const int kp = kbase + mt * 32 + crow(i, h);
          const int dlt = qpos - kp;
          if (dlt > 128 || dlt < -128) s[mt][i] = -INFINITY;
        }
    }
    float mx = s[0][0];
#pragma unroll
    for (int i = 1; i < 16; ++i) mx = fmaxf(mx, s[0][i]);
#pragma unroll
    for (int i = 0; i < 16; ++i) mx = fmaxf(mx, s[1][i]);
    mx = fmaxf(mx, __shfl_xor(mx, 32));
    const float mn = fmaxf(m, mx);
    const float alpha = __expf(m - mn);
    float rs = 0.f;
#pragma unroll
    for (int mt = 0; mt < 2; ++mt)
#pragma unroll
      for (int i = 0; i < 16; ++i) { const float p = __expf(s[mt][i] - mn); s[mt][i] = p; rs += p; }
    lsum = lsum * alpha + rs;
    m = mn;
#pragma unroll
    for (int i = 0; i < 16; ++i) { o[0][i] *= alpha; o[1][i] *= alpha; }
#pragma unroll
    for (int s2 = 0; s2 < 4; ++s2) {
      const int mt = s2 >> 1, ss = s2 & 1;
      u32x4 pb;
#pragma unroll
      for (int j = 0; j < 4; ++j) pb[j] = pack2(s[mt][8 * ss + 2 * j], s[mt][8 * ss + 2 * j + 1]);
      const bf16x8 bfrag = __builtin_bit_cast(bf16x8, pb);
#pragma unroll
      for (int mt2 = 0; mt2 < 2; ++mt2) {
        const bfu* vp = sV + (mt2 * 32 + r) * VS + 32 * mt + 16 * ss + 4 * h;
        bf16x4 lo = *(const bf16x4*)vp, hi = *(const bf16x4*)(vp + 8);
        const bf16x8 a = __builtin_shufflevector(lo, hi, 0, 1, 2, 3, 4, 5, 6, 7);
        o[mt2] = MFMA(a, bfrag, o[mt2]);
      }
    }
  }
  const float ltot = lsum + __shfl_xor(lsum, 32);
  const float inv = 1.f / ltot;
  bfu* orow = Op + (size_t)(wave * 32 + r) * D;
#pragma unroll
  for (int mt2 = 0; mt2 < 2; ++mt2)
#pragma unroll
    for (int g = 0; g < 4; ++g) {
      u32x2 q; q[0] = pack2(o[mt2][4 * g] * inv, o[mt2][4 * g + 1] * inv); q[1] = pack2(o[mt2][4 * g + 2] * inv, o[mt2][4 * g + 3] * inv);
      *(u32x2*)(orow + mt2 * 32 + 8 * g + 4 * h) = q;
    }
}

DI int chunk_row0(int b, int oc) { return oc < 2 ? TL + b * CTX + oc * 128 : b * SEQ + (oc - 2) * 128; }

DI void ssd_state_item(const Params& P, int l, int id, char* lds) {
  const int hd = id & 3, oc = (id >> 2) % NCH, dir = (id / (4 * NCH)) & 1, b = id / (8 * NCH);
  const int tid = threadIdx.x, lane = tid & 63, wave = tid >> 6, r = lane & 31, h = lane >> 5;
  bfu* sX = (bfu*)lds;
  float* sW = (float*)(lds + 64 * 136 * 2);
  const int grow0 = chunk_row0(b, oc), pos0 = oc * 128, g = hd >> 1, col = dir * 4 + hd;
  const float* DT = (const float*)(P.ws + OFF_DT); const float* CS = (const float*)(P.ws + OFF_CS);
  __syncthreads();
  if (tid < 128) {
    const float cs = CS[(size_t)(grow0 + tid) * 8 + col], dt = DT[(size_t)(grow0 + tid) * 8 + col];
    const float tot = CS[(size_t)(grow0 + 127) * 8 + col];
    const float a_neg = -__expf(P.in[I_ALOG][l * 8 + col]);
    sW[tid] = dir == 0 ? dt * __expf(tot - cs) : dt * __expf(cs - dt * a_neg);
  }
  __syncthreads();
  const bfu* XT = (const bfu*)(P.ws + OFF_XT) + ((size_t)(b * 4 + hd) * 64) * SA + pos0;
#pragma unroll
  for (int i = 0; i < 4; ++i) {
    const int c = tid + 256 * i, p = c >> 4, j8 = (c & 15) * 8;
    u32x4 u = *(const u32x4*)(XT + (size_t)p * SA + j8);
    u32x4 q;
#pragma unroll
    for (int j = 0; j < 4; ++j) q[j] = pack2(bflo(u[j]) * sW[j8 + 2 * j], bfhi(u[j]) * sW[j8 + 2 * j + 1]);
    *(u32x4*)(sX + p * 136 + j8) = q;
  }
  __syncthreads();
  f32x16 acc[2];
#pragma unroll
  for (int i = 0; i < 16; ++i) { acc[0][i] = 0.f; acc[1][i] = 0.f; }
  const bfu* BT = (const bfu*)(P.ws + OFF_BT) + ((size_t)(b * 2 + g) * 128 + wave * 32 + r) * SA + pos0 + h * 8;
#pragma unroll
  for (int s = 0; s < 8; ++s) {
    const bf16x8 bb = *(const bf16x8*)(BT + s * 16);
#pragma unroll
    for (int mt = 0; mt < 2; ++mt) {
      const bf16x8 a = *(const bf16x8*)(sX + (mt * 32 + r) * 136 + s * 16 + h * 8);
      acc[mt] = MFMA(a, bb, acc[mt]);
    }
  }
  bfu* ST = (bfu*)(P.ws + OFF_ST) + ((size_t)((b * 2 + dir) * NCH + oc) * 4 + hd) * 8192;
#pragma unroll
  for (int mt = 0; mt < 2; ++mt)
#pragma unroll
    for (int i = 0; i < 16; ++i) ST[(mt * 32 + crow(i, h)) * 128 + wave * 32 + r] = f2bf(acc[mt][i]);
}

DI void phase_scan(const Params& P) {
  const float* CS = (const float*)(P.ws + OFF_CS);
  const int total = NB * 2 * 4 * 1024;
  for (int u = blockIdx.x * 256 + threadIdx.x; u < total; u += gridDim.x * 256) {
    const int e8 = u & 1023, hd = (u >> 10) & 3, dir = (u >> 12) & 1, b = u >> 13;
    float hs[8];
#pragma unroll
    for (int j = 0; j < 8; ++j) hs[j] = 0.f;
    for (int step = 0; step < NCH; ++step) {
      const int oc = dir == 0 ? step : (step < 2 ? 1 - step : 19 - step);
      bfu* p = (bfu*)(P.ws + OFF_ST) + ((size_t)((b * 2 + dir) * NCH + oc) * 4 + hd) * 8192 + e8 * 8;
      const u32x4 st = *(const u32x4*)p;
      u32x4 o;
#pragma unroll
      for (int j = 0; j < 4; ++j) o[j] = pack2(hs[2 * j], hs[2 * j + 1]);
      *(u32x4*)p = o;
      const float dec = __expf(CS[(size_t)(chunk_row0(b, oc) + 127) * 8 + dir * 4 + hd]);
#pragma unroll
      for (int j = 0; j < 4; ++j) { hs[2 * j] = dec * hs[2 * j] + bflo(st[j]); hs[2 * j + 1] = dec * hs[2 * j + 1] + bfhi(st[j]); }
    }
  }
}

DI void ssd_y_item(const Params& P, int l, int b, int oc, int hd, char* lds) {
  const int tid = threadIdx.x, lane = tid & 63, wave = tid >> 6, r = lane & 31, h = lane >> 5;
  bfu* sB = (bfu*)lds;
  bfu* sX = sB + 128 * 136;
  float* sF = (float*)(sX + 64 * 136);
  const int grow0 = chunk_row0(b, oc), pos0 = oc * 128, g = hd >> 1;
  const float* DT = (const float*)(P.ws + OFF_DT); const float* CS = (const float*)(P.ws + OFF_CS);
  const float anb = -__expf(P.in[I_ALOG][l * 8 + 4 + hd]);
  __syncthreads();
  if (tid < 128) {
    const size_t o = (size_t)(grow0 + tid) * 8;
    const float csf = CS[o + hd], dtf = DT[o + hd], csb = CS[o + 4 + hd], dtb = DT[o + 4 + hd];
    sF[tid] = csf; sF[128 + tid] = csb - dtb * anb; sF[256 + tid] = dtf; sF[384 + tid] = dtb;
  }
  const float totb = CS[(size_t)(grow0 + 127) * 8 + 4 + hd];
  {
    const bfu* BMp = (const bfu*)(P.ws + OFF_BM) + ((size_t)(b * 2 + g) * SA + pos0) * 128;
#pragma unroll
    for (int i = 0; i < 8; ++i) { const int c = tid + 256 * i, j = c >> 4, n8 = (c & 15) * 8; *(u32x4*)(sB + j * 136 + n8) = *(const u32x4*)(BMp + (size_t)j * 128 + n8); }
    const bfu* XT = (const bfu*)(P.ws + OFF_XT) + ((size_t)(b * 4 + hd) * 64) * SA + pos0;
#pragma unroll
    for (int i = 0; i < 4; ++i) { const int c = tid + 256 * i, p = c >> 4, j8 = (c & 15) * 8; *(u32x4*)(sX + p * 136 + j8) = *(const u32x4*)(XT + (size_t)p * SA + j8); }
  }
  __syncthreads();
  const int qi = wave * 32 + r;
  bf16x8 cf[8];
  {
    const bfu* CMp = (const bfu*)(P.ws + OFF_CM) + ((size_t)(b * 2 + g) * SA + pos0 + qi) * 128 + h * 8;
#pragma unroll
    for (int s = 0; s < 8; ++s) cf[s] = *(const bf16x8*)(CMp + s * 16);
  }
  f32x16 g4[4];
#pragma unroll
  for (int mt = 0; mt < 4; ++mt) {
#pragma unroll
    for (int i = 0; i < 16; ++i) g4[mt][i] = 0.f;
#pragma unroll
    for (int s = 0; s < 8; ++s) {
      const bf16x8 a = *(const bf16x8*)(sB + (mt * 32 + r) * 136 + s * 16 + h * 8);
      g4[mt] = MFMA(a, cf[s], g4[mt]);
    }
  }
  const float my_csf = sF[qi], my_eb = sF[128 + qi];
#pragma unroll
  for (int mt = 0; mt < 4; ++mt)
#pragma unroll
    for (int i = 0; i < 16; ++i) {
      const int j = mt * 32 + crow(i, h);
      float f = 0.f;
      if (j <= qi) f += __expf(my_csf - sF[j]) * sF[256 + j];
      if (j >= qi) f += __expf(sF[128 + j] - my_eb) * sF[384 + j];
      g4[mt][i] *= f;
    }
  f32x16 y[2];
#pragma unroll
  for (int i = 0; i < 16; ++i) { y[0][i] = 0.f; y[1][i] = 0.f; }
#pragma unroll
  for (int s2 = 0; s2 < 8; ++s2) {
    const int mt = s2 >> 1, ss = s2 & 1;
    u32x4 pb;
#pragma unroll
    for (int j = 0; j < 4; ++j) pb[j] = pack2(g4[mt][8 * ss + 2 * j], g4[mt][8 * ss + 2 * j + 1]);
    const bf16x8 bfrag = __builtin_bit_cast(bf16x8, pb);
#pragma unroll
    for (int mt2 = 0; mt2 < 2; ++mt2) {
      const bfu* vp = sX + (mt2 * 32 + r) * 136 + 32 * mt + 16 * ss + 4 * h;
      bf16x4 lo = *(const bf16x4*)vp, hi = *(const bf16x4*)(vp + 8);
      const bf16x8 a = __builtin_shufflevector(lo, hi, 0, 1, 2, 3, 4, 5, 6, 7);
      y[mt2] = MFMA(a, bfrag, y[mt2]);
    }
  }
#pragma unroll
  for (int dir = 0; dir < 2; ++dir) {
    f32x16 tmp[2];
#pragma unroll
    for (int i = 0; i < 16; ++i) { tmp[0][i] = 0.f; tmp[1][i] = 0.f; }
    const bfu* hin = (const bfu*)(P.ws + OFF_ST) + ((size_t)((b * 2 + dir) * NCH + oc) * 4 + hd) * 8192 + h * 8;
#pragma unroll
    for (int s = 0; s < 8; ++s)
#pragma unroll
      for (int mt2 = 0; mt2 < 2; ++mt2) {
        const bf16x8 a = *(const bf16x8*)(hin + (mt2 * 32 + r) * 128 + s * 16);
        tmp[mt2] = MFMA(a, cf[s], tmp[mt2]);
      }
    const float sc = dir == 0 ? __expf(my_csf) : __expf(totb - my_eb);
#pragma unroll
    for (int i = 0; i < 16; ++i) { y[0][i] += sc * tmp[0][i]; y[1][i] += sc * tmp[1][i]; }
  }
  const float skip = P.in[I_SKIP][l * 4 + hd];
  const int grow = grow0 + qi;
  const bfu* Zr = (const bfu*)(P.ws + OFF_Z) + (size_t)grow * 256 + hd * 64;
  bfu* Or = (bfu*)(P.ws + OFF_NBUF) + (size_t)grow * D + 768 + hd * 64;
  float ss = 0.f;
#pragma unroll
  for (int mt2 = 0; mt2 < 2; ++mt2)
#pragma unroll
    for (int gq = 0; gq < 4; ++gq) {
      const int p0 = mt2 * 32 + 8 * gq + 4 * h;
      const u32x2 zz = *(const u32x2*)(Zr + p0);
      float u4[4];
#pragma unroll
      for (int j = 0; j < 4; ++j) {
        const float x = bf2f(sX[(p0 + j) * 136 + qi]);
        const float z = (j & 1) ? bfhi(zz[j >> 1]) : bflo(zz[j >> 1]);
        const float u = (y[mt2][4 * gq + j] + skip * x) * silu_f(z);
        u4[j] = u; ss += u * u;
      }
      u32x2 q; q[0] = pack2(u4[0], u4[1]); q[1] = pack2(u4[2], u4[3]);
      *(u32x2*)(Or + p0) = q;
    }
  ss += __shfl_xor(ss, 32);
  if (h == 0) atomicAdd((float*)(P.ws + OFF_ROWSS) + grow, ss);
}

DI void phase_ssd_y(const Params& P, int l, char* lds) {
  const int oc_lo = l == 0 ? 0 : 2, noc = NCH - oc_lo;
  const int total = NB * noc * 4;
  for (int it = blockIdx.x; it < total; it += gridDim.x) {
    const int hd = it & 3, oc = oc_lo + (it >> 2) % noc, b = (it >> 2) / noc;
    ssd_y_item(P, l, b, oc, hd, lds);
  }
}

DI void phase_attn(const Params& P, int l, char* lds) {
  const int nB = 512, nC = 512, nA = 512, nS = NB * 2 * NCH * 4, nX = l == 0 ? 192 : 0;
  const int total = nB + nC + nA + nS + nX;
  bfu* O = (bfu*)(P.ws + OFF_NBUF);
  for (int it = blockIdx.x; it < total; it += gridDim.x) {
    if (it < nB + nC + nA) {
      const int mixer = it < nB ? 1 : (it < nB + nC ? 2 : 0);
      const int id = it < nB ? it : (it < nB + nC ? it - nB : it - nB - nC);
      const int b = id >> 6, hq = (id >> 4) & 3, qb = id & 15;
      const int q0 = qb * 128;
      bfu* Op = O + (size_t)(b * SEQ + q0) * D + (mixer == 0 ? 0 : (mixer == 1 ? 256 : 512)) + hq * 64;
      if (mixer == 1) {
        const bfu* Qp = (const bfu*)(P.ws + OFF_QB) + ((size_t)(b * 4 + hq) * SA + CTX + q0) * 64;
        const bfu* Kp = (const bfu*)(P.ws + OFF_KB) + (size_t)(b * 2 + (hq >> 1)) * SA * 64;
        const bfu* Vp = (const bfu*)(P.ws + OFF_VTB) + (size_t)(b * 2 + (hq >> 1)) * 64 * SA;
        attn_item<64>(Qp, Kp, Vp, 36, 0, 0, 0, false, 0, false, 0.f, Op, lds);
      } else if (mixer == 2) {
        const bfu* Qp = (const bfu*)(P.ws + OFF_QC) + ((size_t)(b * 4 + hq) * SA + CTX + q0) * 96;
        const bfu* Kp = (const bfu*)(P.ws + OFF_KC) + (size_t)(b * 4 + hq) * SA * 96;
        const bfu* Vp = (const bfu*)(P.ws + OFF_VTC) + (size_t)(b * 4 + hq) * 64 * SA;
        attn_item<96>(Qp, Kp, Vp, 36, 0, 0, 0, false, 0, false, 0.f, Op, lds);
      } else {
        const bfu* Qp = (const bfu*)(P.ws + OFF_QA) + ((size_t)(b * 4 + hq) * SA + CTX + q0) * 64;
        const bfu* Kp = (const bfu*)(P.ws + OFF_KA) + (size_t)(b * 2 + (hq >> 1)) * SA * 64;
        const bfu* Vp = (const bfu*)(P.ws + OFF_VTA) + (size_t)(b * 2 + (hq >> 1)) * 64 * SA;
        const int lo = q0 - 128 < 0 ? 0 : q0 - 128, hi = q0 + 256 > SEQ ? SEQ : q0 + 256;
        attn_item<64>(Qp, Kp, Vp, 4, 0, (hi - lo) >> 6, CTX + lo, true, q0, true, P.in[I_SINK][l * 4 + hq], Op, lds);
      }
    } else if (it < nB + nC + nA + nS) {
      ssd_state_item(P, l, it - (nB + nC + nA), lds);
    } else {
      const int id = it - (nB + nC + nA + nS);
      const int mixer = id >> 6, b = (id >> 3) & 7, hq = (id >> 1) & 3, qb = id & 1;
      const int q0 = qb * 128;
      bfu* Op = O + (size_t)(TL + b * CTX + q0) * D + mixer * 256 + hq * 64;
      if (mixer == 2) {
        const bfu* Qp = (const bfu*)(P.ws + OFF_QC) + ((size_t)(b * 4 + hq) * SA + q0) * 96;
        const bfu* Kp = (const bfu*)(P.ws + OFF_KC) + (size_t)(b * 4 + hq) * SA * 96;
        const bfu* Vp = (const bfu*)(P.ws + OFF_VTC) + (size_t)(b * 4 + hq) * 64 * SA;
        attn_item<96>(Qp, Kp, Vp, 4, 0, 0, 0, false, 0, false, 0.f, Op, lds);
      } else {
        const bfu* Qp = (const bfu*)(P.ws + (mixer ? OFF_QB : OFF_QA)) + ((size_t)(b * 4 + hq) * SA + q0) * 64;
        const bfu* Kp = (const bfu*)(P.ws + (mixer ? OFF_KB : OFF_KA)) + (size_t)(b * 2 + (hq >> 1)) * SA * 64;
        const bfu* Vp = (const bfu*)(P.ws + (mixer ? OFF_VTB : OFF_VTA)) + (size_t)(b * 2 + (hq >> 1)) * 64 * SA;
        attn_item<64>(Qp, Kp, Vp, 4, 0, 0, 0, false, 0, mixer == 0, mixer == 0 ? P.in[I_SINK][l * 4 + hq] : 0.f, Op, lds);
      }
    }
  }
}

constexpr int PH_PER_LAYER = 14;
constexpr int N_PHASES = 2 * PH_PER_LAYER + 1;

template <int L>
DI void run_layer(const Params& P, cg::grid_group& grid, char* lds) {
  const bfu* Wb = (const bfu*)(P.ws + OFF_W);
  const float* hc = (const float*)(P.ws + OFF_HC);
  constexpr int M2 = L == 0 ? T : TL;
  const float* s_lat = L == 0 ? P.in[I_X] : P.out;
  const float* s_ctx = L == 0 ? P.in[I_CTX] : hc;
  const int lo = P.ph_lo, hi = P.ph_hi;
#define PH(k, body) { const int ph_ = L * PH_PER_LAYER + (k); if (lo <= ph_ && ph_ < hi) { body; if (ph_ + 1 < hi) grid.sync(); } }
  PH(0, phase_convert(P, L, lds))
  PH(1, phase_norm(P, s_lat, s_ctx, P.in[I_F1N] + L * D, 0, 1, T, false))
  PH(2, phase_gemm_swiglu(P, Wb + W_WI1, T, lds))
  PH(3, phase_gemm_resid(P, (const bfu*)(P.ws + OFF_ACT), FFN, Wb + W_WO1, T, 2, 0.5f, s_lat, s_ctx, 0, nullptr, lds))
  PH(4, phase_norm(P, P.out, hc, P.in[I_MIXN] + L * D, 3, 4, T, true))
  PH(5, phase_gemm_win(P, L, lds))
  PH(6, phase_mla_conv(P, L, lds))
  PH(7, phase_attn(P, L, lds))
  PH(8, phase_scan(P))
  PH(9, phase_ssd_y(P, L, lds))
  PH(10, phase_gemm_resid(P, (const bfu*)(P.ws + OFF_NBUF), D, Wb + W_WOUT, M2, 5, 1.0f, P.out, hc, 12, (const float*)(P.ws + OFF_ROWSS), lds))
  PH(11, phase_norm(P, P.out, hc, P.in[I_F2N] + L * D, 6, 7, M2, false))
  PH(12, phase_gemm_swiglu(P, Wb + W_WI2, M2, lds))
  PH(13, phase_gemm_resid(P, (const bfu*)(P.ws + OFF_ACT), FFN, Wb + W_WO2, M2, 8, 0.5f, P.out, hc, 0, nullptr, lds))
#undef PH
}

__global__ void __launch_bounds__(256, 2) fwd_kernel(Params P) {
  extern __shared__ __attribute__((aligned(16))) char lds[];
  cg::grid_group grid = cg::this_grid();
  run_layer<0>(P, grid, lds);
  run_layer<1>(P, grid, lds);
  if (P.ph_lo <= N_PHASES - 1 && N_PHASES - 1 < P.ph_hi) phase_final(P);
}

extern "C" void kernel_launch(void* const* d_in, const int* in_sizes, int n_in, void* d_out, int out_size, void* d_ws, size_t ws_size,
                              hipStream_t stream) {
  static int grid_blocks = 0;
  if (grid_blocks == 0) {
    if (ws_size < OFF_END) { fprintf(stderr, "kernel_launch: workspace too small: %zu < %zu\n", ws_size, (size_t)OFF_END); grid_blocks = -1; return; }
    int dev = 0, cus = 0, per_cu = 0;
    (void)hipGetDevice(&dev);
    (void)hipDeviceGetAttribute(&cus, hipDeviceAttributeMultiprocessorCount, dev);
    if (hipFuncSetAttribute((const void*)fwd_kernel, hipFuncAttributeMaxDynamicSharedMemorySize, LDS_BYTES) != hipSuccess) {
      fprintf(stderr, "kernel_launch: hipFuncSetAttribute failed\n"); grid_blocks = -1; return; }
    (void)hipOccupancyMaxActiveBlocksPerMultiprocessor(&per_cu, (const void*)fwd_kernel, 256, LDS_BYTES);
    if (per_cu < 1) { fprintf(stderr, "kernel_launch: occupancy query returned %d\n", per_cu); grid_blocks = -1; return; }
    if (per_cu > 2) per_cu = 2;
    grid_blocks = cus * per_cu;
    fprintf(stderr, "kernel_launch: grid %d (%d per CU), ws need %zu have %zu\n", grid_blocks, per_cu, (size_t)OFF_END, ws_size);
  }
  if (grid_blocks < 0) return;
  Params p{};
  for (int i = 0; i < 29; ++i) p.in[i] = (const float*)d_in[i];
  p.out = (float*)d_out; p.ws = (unsigned char*)d_ws;
#if MULTI_LAUNCH
  for (int ph = 0; ph < N_PHASES; ++ph) {
    p.ph_lo = ph; p.ph_hi = ph + 1;
    void* args[] = {&p};
    (void)hipLaunchCooperativeKernel((const void*)fwd_kernel, dim3(grid_blocks), dim3(256), args, LDS_BYTES, stream);
  }
#else
  p.ph_lo = 0; p.ph_hi = N_PHASES;
  void* args[] = {&p};
  hipError_t e = hipLaunchCooperativeKernel((const void*)fwd_kernel, dim3(grid_blocks), dim3(256), args, LDS_BYTES, stream);
  if (e != hipSuccess) fprintf(stderr, "cooperative launch failed: %s (grid %d)\n", hipGetErrorString(e), grid_blocks);
#endif
}
```

```cpp
#include <hip/hip_runtime.h>
#include <hip/hip_cooperative_groups.h>
#include <cstdio>
namespace cg = cooperative_groups;

#ifndef MULTI_LAUNCH
#define MULTI_LAUNCH 0
#endif

#define DI __device__ __forceinline__
typedef unsigned short bfu;
typedef __attribute__((ext_vector_type(8))) short bf16x8;
typedef __attribute__((ext_vector_type(4))) short bf16x4;
typedef __attribute__((ext_vector_type(16))) float f32x16;
typedef __attribute__((ext_vector_type(2))) __bf16 bf2_t;
typedef __attribute__((ext_vector_type(2))) float f2_t;
typedef __attribute__((ext_vector_type(4))) unsigned u32x4;
typedef __attribute__((ext_vector_type(2))) unsigned u32x2;

#define MFMA(a, b, c) __builtin_amdgcn_mfma_f32_32x32x16_bf16((a), (b), (c), 0, 0, 0)

DI unsigned pack2(float a, float b) { f2_t v = {a, b}; return __builtin_bit_cast(unsigned, __builtin_convertvector(v, bf2_t)); }
DI bfu f2bf(float a) { return (bfu)(pack2(a, 0.f) & 0xffffu); }
DI float bf2f(bfu v) { return __uint_as_float(((unsigned)v) << 16); }
DI float bflo(unsigned u) { return __uint_as_float(u << 16); }
DI float bfhi(unsigned u) { return __uint_as_float(u & 0xffff0000u); }
DI int crow(int reg, int h) { return (reg & 3) + 8 * (reg >> 2) + 4 * h; }
DI float silu_f(float x) { return x / (1.f + __expf(-x)); }

constexpr int D = 1024, SEQ = 2048, CTX = 256, NB = 8, FFN = 2816;
constexpr int TL = NB * SEQ;
constexpr int TC = NB * CTX;
constexpr int T = TL + TC;
constexpr int SA = CTX + SEQ;
constexpr int NWIN = 2688;
constexpr int NMOD = 9 * D;
constexpr float EPS = 1e-6f;
constexpr int NCH = 18;

constexpr size_t al(size_t x) { return (x + 255) & ~(size_t)255; }
constexpr size_t E_WI = (size_t)2 * FFN * D, E_WO = (size_t)D * FFN, E_WIN = (size_t)NWIN * D, E_WOUT = (size_t)D * D;
constexpr size_t E_UQ = 512 * 256, E_UKV = 512 * 128;
constexpr size_t W_WI1 = 0, W_WO1 = W_WI1 + E_WI, W_WIN = W_WO1 + E_WO, W_WOUT = W_WIN + E_WIN, W_WI2 = W_WOUT + E_WOUT,
                 W_WO2 = W_WI2 + E_WI, W_UQ = W_WO2 + E_WO, W_UKV = W_UQ + E_UQ, W_END = W_UKV + E_UKV;
constexpr size_t OFF_BAR = 0;
constexpr size_t OFF_W = 16384;
constexpr size_t OFF_MODS = al(OFF_W + W_END * 2);
constexpr size_t OFF_HC = al(OFF_MODS + (size_t)9 * NMOD * 4);
constexpr size_t OFF_NBUF = al(OFF_HC + (size_t)TC * D * 4);
constexpr size_t OFF_ROWSS = al(OFF_NBUF + (size_t)T * D * 2);
constexpr size_t OFF_MIX = al(OFF_ROWSS + (size_t)T * 4);
constexpr size_t OFF_ACT = OFF_MIX;
constexpr size_t SZ_Q = (size_t)NB * 4 * SA * 64 * 2, SZ_KV = (size_t)NB * 2 * SA * 64 * 2;
constexpr size_t OFF_QA = OFF_MIX, OFF_KA = al(OFF_QA + SZ_Q), OFF_VTA = al(OFF_KA + SZ_KV);
constexpr size_t OFF_QB = al(OFF_VTA + SZ_KV), OFF_KB = al(OFF_QB + SZ_Q), OFF_VTB = al(OFF_KB + SZ_KV);
constexpr size_t OFF_CQ = al(OFF_VTB + SZ_KV), OFF_CKV = al(OFF_CQ + (size_t)T * 256 * 2);
constexpr size_t OFF_QC = al(OFF_CKV + (size_t)T * 128 * 2), OFF_KC = al(OFF_QC + (size_t)NB * 4 * SA * 96 * 2);
constexpr size_t OFF_VTC = al(OFF_KC + (size_t)NB * 4 * SA * 96 * 2);
constexpr size_t OFF_Z = al(OFF_VTC + (size_t)NB * 4 * 64 * SA * 2), OFF_XBC = al(OFF_Z + (size_t)T * 256 * 2);
constexpr size_t OFF_DT = al(OFF_XBC + (size_t)T * 768 * 2), OFF_CS = al(OFF_DT + (size_t)T * 8 * 4);
constexpr size_t OFF_XT = al(OFF_CS + (size_t)T * 8 * 4), OFF_BM = al(OFF_XT + (size_t)NB * 4 * 64 * SA * 2);
constexpr size_t OFF_BT = al(OFF_BM + (size_t)NB * 2 * SA * 128 * 2), OFF_CM = al(OFF_BT + (size_t)NB * 2 * SA * 128 * 2);
constexpr size_t OFF_ST = al(OFF_CM + (size_t)NB * 2 * SA * 128 * 2);
constexpr size_t OFF_END = al(OFF_ST + (size_t)NB * 2 * NCH * 4 * 8192 * 2);
static_assert(OFF_ACT + (size_t)T * FFN * 2 <= OFF_END, "act alias fits");

constexpr int LDS_BYTES = 75776;

struct Params {
  const float* in[29];
  float* out;
  unsigned char* ws;
  int ph_lo, ph_hi;
};
enum { I_X = 0, I_C, I_CTX, I_CCTX, I_ADAW, I_ADAB, I_F1N, I_F1WI, I_F1WO, I_MIXN, I_WIN, I_WOUT, I_SINK, I_BQN, I_BKN, I_CQN, I_CWUQ,
       I_CKVN, I_CWUKV, I_CONVW, I_CONVB, I_ALOG, I_DTB, I_SKIP, I_ONORM, I_F2N, I_F2WI, I_F2WO, I_FINAL };

DI int row_b(int row) { return row < TL ? row / SEQ : (row - TL) / CTX; }
DI int row_pos(int row) { return row < TL ? CTX + row % SEQ : (row - TL) % CTX; }
DI int row_mrow(int row) { return row < TL ? row / SEQ : 8; }

DI int wmap(int wid, int n) {
  if (wid == 0) {
    int bn = n >> 7, wn = (n >> 6) & 1, nt = (n >> 5) & 1, c = n & 31;
    return nt * FFN + bn * 64 + wn * 32 + c;
  } else if (wid == 2) {
    if (n < 1024) return n;
    if (n < 1536) { int c = n - 1024; return c < 416 ? 1024 + c : -1; }
    int c = n - 1536; return c < 1032 ? 1440 + c : -1;
  } else if (wid == 4) {
    int hd = n >> 7, c = n & 127; return c < 96 ? hd * 96 + c : -1;
  }
  return n;
}

DI void conv_weight_tile(const float* __restrict__ W, int K, int N, bfu* __restrict__ Wt, int n0, int k0, int wid,
                         const float* __restrict__ ksc, int ksc_lo, float* sT) {
  const int tid = threadIdx.x;
#pragma unroll
  for (int i = 0; i < 16; ++i) {
    int idx = tid + 256 * i, kk = idx >> 6, nn = idx & 63;
    int col = wmap(wid, n0 + nn);
    float v = col >= 0 ? W[(size_t)(k0 + kk) * N + col] : 0.f;
    if (ksc && (k0 + kk) >= ksc_lo) v *= ksc[k0 + kk - ksc_lo];
    sT[nn * 65 + kk] = v;
  }
  __syncthreads();
#pragma unroll
  for (int i = 0; i < 2; ++i) {
    int idx = tid + 256 * i, nn = idx >> 3, kc = idx & 7;
    const float* s = sT + nn * 65 + kc * 8;
    u32x4 o; o[0] = pack2(s[0], s[1]); o[1] = pack2(s[2], s[3]); o[2] = pack2(s[4], s[5]); o[3] = pack2(s[6], s[7]);
    *(u32x4*)(Wt + (size_t)(n0 + nn) * K + k0 + kc * 8) = o;
  }
  __syncthreads();
}

DI void phase_convert(const Params& P, int l, char* lds) {
  float* sT = (float*)lds;
  bfu* Wb = (bfu*)(P.ws + OFF_W);
  const int t_wi = 88 * 16, t_wo = 16 * 44, t_win = 42 * 16, t_wout = 16 * 16, t_uq = 8 * 4, t_ukv = 8 * 2;
  const int c0 = t_wi, c1 = c0 + t_wo, c2 = c1 + t_win, c3 = c2 + t_wout, c4 = c3 + t_wi, c5 = c4 + t_wo, c6 = c5 + t_uq, c7 = c6 + t_ukv;
  const int n_mod = 288;
  const int total = c7 + n_mod;
  for (int it = blockIdx.x; it < total; it += gridDim.x) {
    if (it < c7) {
      const float* W; int K, N, wid, id; bfu* Wt; const float* ksc = nullptr; int ksc_lo = 0; int nkt;
      if (it < c0)      { id = it;      W = P.in[I_F1WI] + (size_t)l * D * 2 * FFN; K = D; N = 2 * FFN; wid = 0; Wt = Wb + W_WI1; }
      else if (it < c1) { id = it - c0; W = P.in[I_F1WO] + (size_t)l * FFN * D; K = FFN; N = D; wid = 1; Wt = Wb + W_WO1; }
      else if (it < c2) { id = it - c1; W = P.in[I_WIN] + (size_t)l * D * 2472; K = D; N = 2472; wid = 2; Wt = Wb + W_WIN; }
      else if (it < c3) { id = it - c2; W = P.in[I_WOUT] + (size_t)l * D * D; K = D; N = D; wid = 3; Wt = Wb + W_WOUT; ksc = P.in[I_ONORM] + l * 256; ksc_lo = 768; }
      else if (it < c4) { id = it - c3; W = P.in[I_F2WI] + (size_t)l * D * 2 * FFN; K = D; N = 2 * FFN; wid = 0; Wt = Wb + W_WI2; }
      else if (it < c5) { id = it - c4; W = P.in[I_F2WO] + (size_t)l * FFN * D; K = FFN; N = D; wid = 1; Wt = Wb + W_WO2; }
      else if (it < c6) { id = it - c5; W = P.in[I_CWUQ] + (size_t)l * 256 * 384; K = 256; N = 384; wid = 4; Wt = Wb + W_UQ; ksc = P.in[I_CQN] + l * 256; }
      else              { id = it - c6; W = P.in[I_CWUKV] + (size_t)l * 128 * 512; K = 128; N = 512; wid = 5; Wt = Wb + W_UKV; ksc = P.in[I_CKVN] + l * 128; }
      nkt = K / 64;
      conv_weight_tile(W, K, N, Wt, (id / nkt) * 64, (id % nkt) * 64, wid, ksc, ksc_lo, sT);
    } else {
      const int id = it - c7, tid = threadIdx.x;
      float* sS = sT;
      float* sR = sT + 9 * 1024;
      for (int i = tid; i < 9 * 1024; i += 256) {
        int rr = i >> 10, k = i & 1023;
        float cv = rr < 8 ? P.in[I_C][rr * 1024 + k] : P.in[I_CCTX][k];
        sS[i] = silu_f(cv);
      }
      __syncthreads();
      const int col = id * 32 + (tid & 31), kq = tid >> 5;
      const float* W = P.in[I_ADAW] + (size_t)l * D * NMOD + col;
      float acc[9];
#pragma unroll
      for (int j = 0; j < 9; ++j) acc[j] = 0.f;
      for (int kb = kq * 128; kb < kq * 128 + 128; kb += 32) {
        float w[32];
#pragma unroll
        for (int u = 0; u < 32; ++u) w[u] = W[(size_t)(kb + u) * NMOD];
#pragma unroll
        for (int u = 0; u < 32; ++u)
#pragma unroll
          for (int j = 0; j < 9; ++j) acc[j] += sS[j * 1024 + kb + u] * w[u];
      }
#pragma unroll
      for (int j = 0; j < 9; ++j) sR[(kq * 9 + j) * 32 + (tid & 31)] = acc[j];
      __syncthreads();
      for (int i = tid; i < 9 * 32; i += 256) {
        int j = i >> 5, cc = i & 31;
        float s = 0.f;
#pragma unroll
        for (int q = 0; q < 8; ++q) s += sR[(q * 9 + j) * 32 + cc];
        int c2_ = id * 32 + cc;
        ((float*)(P.ws + OFF_MODS))[j * NMOD + c2_] = s + P.in[I_ADAB][l * NMOD + c2_];
      }
      __syncthreads();
    }
  }
}

DI void phase_norm(const Params& P, const float* src_lat, const float* src_ctx, const float* g, int shift_idx, int scale_idx, int M, bool zero_rowss) {
  const int lane = threadIdx.x & 63, wave = threadIdx.x >> 6;
  const float* mods = (const float*)(P.ws + OFF_MODS);
  bfu* dst = (bfu*)(P.ws + OFF_NBUF);
  float* rowss = (float*)(P.ws + OFF_ROWSS);
  for (int row = blockIdx.x * 4 + wave; row < M; row += gridDim.x * 4) {
    const float* src = row < TL ? src_lat + (size_t)row * D : src_ctx + (size_t)(row - TL) * D;
    float4 v[4]; float ss = 0.f;
#pragma unroll
    for (int i = 0; i < 4; ++i) { v[i] = ((const float4*)src)[lane + 64 * i]; ss += v[i].x * v[i].x + v[i].y * v[i].y + v[i].z * v[i].z + v[i].w * v[i].w; }
#pragma unroll
    for (int o = 32; o >= 1; o >>= 1) ss += __shfl_xor(ss, o);
    const float r = rsqrtf(ss * (1.f / D) + EPS);
    const float* msh = mods + row_mrow(row) * NMOD + shift_idx * D;
    const float* msc = mods + row_mrow(row) * NMOD + scale_idx * D;
#pragma unroll
    for (int i = 0; i < 4; ++i) {
      const int c = (lane + 64 * i) * 4;
      float4 gg = *(const float4*)(g + c), sh = *(const float4*)(msh + c), sc = *(const float4*)(msc + c);
      float a0 = v[i].x * r * gg.x * (1.f + sc.x) + sh.x, a1 = v[i].y * r * gg.y * (1.f + sc.y) + sh.y;
      float a2 = v[i].z * r * gg.z * (1.f + sc.z) + sh.z, a3 = v[i].w * r * gg.w * (1.f + sc.w) + sh.w;
      u32x2 o; o[0] = pack2(a0, a1); o[1] = pack2(a2, a3);
      *(u32x2*)(dst + (size_t)row * D + c) = o;
    }
    if (zero_rowss && lane == 0) rowss[row] = 0.f;
  }
}

DI void phase_final(const Params& P) {
  const int lane = threadIdx.x & 63, wave = threadIdx.x >> 6;
  const float* g = P.in[I_FINAL];
  for (int row = blockIdx.x * 4 + wave; row < TL; row += gridDim.x * 4) {
    float* src = P.out + (size_t)row * D;
    float4 v[4]; float ss = 0.f;
#pragma unroll
    for (int i = 0; i < 4; ++i) { v[i] = ((const float4*)src)[lane + 64 * i]; ss += v[i].x * v[i].x + v[i].y * v[i].y + v[i].z * v[i].z + v[i].w * v[i].w; }
#pragma unroll
    for (int o = 32; o >= 1; o >>= 1) ss += __shfl_xor(ss, o);
    const float r = rsqrtf(ss * (1.f / D) + EPS);
#pragma unroll
    for (int i = 0; i < 4; ++i) {
      const int c = (lane + 64 * i) * 4;
      float4 gg = *(const float4*)(g + c);
      float4 o = {v[i].x * r * gg.x, v[i].y * r * gg.y, v[i].z * r * gg.z, v[i].w * r * gg.w};
      ((float4*)src)[lane + 64 * i] = o;
    }
  }
}

constexpr int LDSS = 72;
constexpr int TILE_E = 128 * LDSS;

DI void gemm_mainloop(const bfu* __restrict__ A, int lda, const bfu* __restrict__ W, int K, int bm, int bn, int kshift,
                      const float* rowss, char* lds, f32x16 (&acc)[2][2]) {
  bfu* sA = (bfu*)lds;
  bfu* sB = sA + 2 * TILE_E;
  const int tid = threadIdx.x, lane = tid & 63, wave = tid >> 6, r = lane & 31, h = lane >> 5;
  const int wm = wave >> 1, wn = wave & 1;
  const int nk = K / 64;
#pragma unroll
  for (int a = 0; a < 2; ++a)
#pragma unroll
    for (int b = 0; b < 2; ++b)
#pragma unroll
      for (int i = 0; i < 16; ++i) acc[a][b][i] = 0.f;
  const bfu* Ag = A + (size_t)(bm * 128 + (tid >> 3)) * lda + (tid & 7) * 8;
  const bfu* Wg = W + (size_t)(bn * 128 + (tid >> 3)) * K + (tid & 7) * 8;
  const int soff = (tid >> 3) * LDSS + (tid & 7) * 8;
  u32x4 ra[4], rb[4];
  {
    const int k0 = ((0 + kshift) % nk) * 64;
#pragma unroll
    for (int i = 0; i < 4; ++i) { ra[i] = *(const u32x4*)(Ag + (size_t)(32 * i) * lda + k0); rb[i] = *(const u32x4*)(Wg + (size_t)(32 * i) * K + k0); }
#pragma unroll
    for (int i = 0; i < 4; ++i) { *(u32x4*)(sA + soff + 32 * i * LDSS) = ra[i]; *(u32x4*)(sB + soff + 32 * i * LDSS) = rb[i]; }
  }
  __syncthreads();
  for (int kt = 0; kt < nk; ++kt) {
    const int cur = kt & 1;
    if (kt + 1 < nk) {
      const int k0 = ((kt + 1 + kshift) % nk) * 64;
#pragma unroll
      for (int i = 0; i < 4; ++i) { ra[i] = *(const u32x4*)(Ag + (size_t)(32 * i) * lda + k0); rb[i] = *(const u32x4*)(Wg + (size_t)(32 * i) * K + k0); }
    }
    const bfu* cA = sA + cur * TILE_E + (wm * 64 + r) * LDSS + h * 8;
    const bfu* cB = sB + cur * TILE_E + (wn * 64 + r) * LDSS + h * 8;
#pragma unroll
    for (int s = 0; s < 4; ++s) {
      bf16x8 a0 = *(const bf16x8*)(cA + s * 16), a1 = *(const bf16x8*)(cA + 32 * LDSS + s * 16);
      bf16x8 b0 = *(const bf16x8*)(cB + s * 16), b1 = *(const bf16x8*)(cB + 32 * LDSS + s * 16);
      acc[0][0] = MFMA(a0, b0, acc[0][0]); acc[0][1] = MFMA(a0, b1, acc[0][1]);
      acc[1][0] = MFMA(a1, b0, acc[1][0]); acc[1][1] = MFMA(a1, b1, acc[1][1]);
    }
    if (rowss != nullptr && kt == 3) {
#pragma unroll
      for (int mt = 0; mt < 2; ++mt)
#pragma unroll
        for (int i = 0; i < 16; ++i) {
          const int row = bm * 128 + wm * 64 + mt * 32 + crow(i, h);
          const float rs = rsqrtf(rowss[row] * (1.f / 256.f) + EPS);
          acc[mt][0][i] *= rs; acc[mt][1][i] *= rs;
        }
    }
    if (kt + 1 < nk) {
      bfu* dA = sA + (cur ^ 1) * TILE_E + soff; bfu* dB = sB + (cur ^ 1) * TILE_E + soff;
#pragma unroll
      for (int i = 0; i < 4; ++i) { *(u32x4*)(dA + 32 * i * LDSS) = ra[i]; *(u32x4*)(dB + 32 * i * LDSS) = rb[i]; }
    }
    __syncthreads();
  }
}

DI void tile_coords(int id, int NT, int& bm, int& bn) { const int per = 16 * NT; const int sg = id / per, rem = id % per; bm = sg * 16 + (rem & 15); bn = rem >> 4; }

constexpr int SCS = 129;
DI void stage_acc(float* sC, const f32x16 (&acc)[2][2]) {
  const int lane = threadIdx.x & 63, wave = threadIdx.x >> 6, r = lane & 31, h = lane >> 5, wm = wave >> 1, wn = wave & 1;
#pragma unroll
  for (int mt = 0; mt < 2; ++mt)
#pragma unroll
    for (int nt = 0; nt < 2; ++nt)
#pragma unroll
      for (int i = 0; i < 16; ++i) sC[(wm * 64 + mt * 32 + crow(i, h)) * SCS + wn * 64 + nt * 32 + r] = acc[mt][nt][i];
}

DI void phase_gemm_swiglu(const Params& P, const bfu* Wt, int M, char* lds) {
  const bfu* A = (const bfu*)(P.ws + OFF_NBUF);
  bfu* act = (bfu*)(P.ws + OFF_ACT);
  const int NT = 44, ntiles = (M / 128) * NT;
  const int lane = threadIdx.x & 63, wave = threadIdx.x >> 6, r = lane & 31, h = lane >> 5, wm = wave >> 1, wn = wave & 1;
  for (int t = blockIdx.x; t < ntiles; t += gridDim.x) {
    int bm, bn; tile_coords(t, NT, bm, bn);
    f32x16 acc[2][2];
    gemm_mainloop(A, D, Wt, D, bm, bn, 0, nullptr, lds, acc);
#pragma unroll
    for (int mt = 0; mt < 2; ++mt)
#pragma unroll
      for (int i = 0; i < 16; ++i) {
        const int row = bm * 128 + wm * 64 + mt * 32 + crow(i, h);
        const float a = acc[mt][0][i], b = acc[mt][1][i];
        act[(size_t)row * FFN + bn * 64 + wn * 32 + r] = f2bf(silu_f(a) * b);
      }
  }
}

DI void phase_gemm_resid(const Params& P, const bfu* A, int K, const bfu* Wt, int M, int gidx, float gs,
                         const float* src_lat, const float* src_ctx, int kshift, const float* rowss, char* lds) {
  const float* mods = (const float*)(P.ws + OFF_MODS);
  float* dst_lat = P.out; float* dst_ctx = (float*)(P.ws + OFF_HC);
  const int NT = 8, ntiles = (M / 128) * NT;
  const int lane = threadIdx.x & 63, wave = threadIdx.x >> 6, r = lane & 31, h = lane >> 5, wm = wave >> 1, wn = wave & 1;
  for (int t = blockIdx.x; t < ntiles; t += gridDim.x) {
    int bm, bn; tile_coords(t, NT, bm, bn);
    f32x16 acc[2][2];
    gemm_mainloop(A, K, Wt, K, bm, bn, kshift, rowss, lds, acc);
    const int row0 = bm * 128;
    const float* gate = mods + row_mrow(row0) * NMOD + gidx * D;
    const bool lat = row0 < TL;
#pragma unroll
    for (int mt = 0; mt < 2; ++mt)
#pragma unroll
      for (int nt = 0; nt < 2; ++nt)
#pragma unroll
        for (int i = 0; i < 16; ++i) {
          const int row = row0 + wm * 64 + mt * 32 + crow(i, h);
          const int col = bn * 128 + wn * 64 + nt * 32 + r;
          const size_t off = lat ? (size_t)row * D + col : (size_t)(row - TL) * D + col;
          const float s = lat ? src_lat[off] : src_ctx[off];
          const float v = s + gs * gate[col] * acc[mt][nt][i];
          if (lat) dst_lat[off] = v; else dst_ctx[off] = v;
        }
  }
}

template <int NF>
DI void rope2d(float* v, int t) {
  const float ri = (float)(t >> 6), ci = (float)(t & 63);
#pragma unroll
  for (int d = 0; d < NF; ++d) {
    const float inv = exp2f(-(float)d * (13.287712379549449f / NF));
    float ar = ri * inv, ac = ci * inv;
    float cr = __cosf(ar), sr = __sinf(ar), cc = __cosf(ac), sc = __sinf(ac);
    float x1 = v[d], x2 = v[NF + d];
    v[d] = x1 * cr - x2 * sr; v[NF + d] = x2 * cr + x1 * sr;
    float y1 = v[2 * NF + d], y2 = v[3 * NF + d];
    v[2 * NF + d] = y1 * cc - y2 * sc; v[3 * NF + d] = y2 * cc + y1 * sc;
  }
}

DI void store_row_bf16_64(bfu* dst, const float* v) {
#pragma unroll
  for (int c = 0; c < 8; ++c) {
    u32x4 o; o[0] = pack2(v[c * 8], v[c * 8 + 1]); o[1] = pack2(v[c * 8 + 2], v[c * 8 + 3]); o[2] = pack2(v[c * 8 + 4], v[c * 8 + 5]); o[3] = pack2(v[c * 8 + 6], v[c * 8 + 7]);
    *(u32x4*)(dst + c * 8) = o;
  }
}

DI void write_raw_rows(const float* sC, bfu* dst, int pitch, int col0, int grow0) {
  const int tid = threadIdx.x, rr = tid & 127, half = tid >> 7;
  float v[64];
#pragma unroll
  for (int j = 0; j < 64; ++j) v[j] = sC[rr * SCS + half * 64 + j];
  store_row_bf16_64(dst + (size_t)(grow0 + rr) * pitch + col0 + half * 64, v);
}

DI void write_col_T(const float* sC, int col, int half, bfu* dstT, float sc0, const float* rscale) {
#pragma unroll
  for (int c = 0; c < 8; ++c) {
    float v[8];
#pragma unroll
    for (int j = 0; j < 8; ++j) { const int rr = half * 64 + c * 8 + j; v[j] = sC[rr * SCS + col] * (rscale ? rscale[rr] : sc0); }
    u32x4 o; o[0] = pack2(v[0], v[1]); o[1] = pack2(v[2], v[3]); o[2] = pack2(v[4], v[5]); o[3] = pack2(v[6], v[7]);
    *(u32x4*)(dstT + half * 64 + c * 8) = o;
  }
}

DI void phase_gemm_win(const Params& P, int l, char* lds) {
  const bfu* A = (const bfu*)(P.ws + OFF_NBUF);
  const bfu* Wt = (const bfu*)(P.ws + OFF_W) + W_WIN;
  float* sC = (float*)lds;
  const int NT = 21, ntiles = 144 * NT;
  const int tid = threadIdx.x;
  for (int t = blockIdx.x; t < ntiles; t += gridDim.x) {
    int bm, bn; tile_coords(t, NT, bm, bn);
    f32x16 acc[2][2];
    gemm_mainloop(A, D, Wt, D, bm, bn, 0, nullptr, lds, acc);
    stage_acc(sC, acc);
    __syncthreads();
    const int grow0 = bm * 128;
    const bool lat = grow0 < TL;
    const int b = row_b(grow0), pos0 = row_pos(grow0);
    if (bn < 8) {
      const int mixer = bn >> 2, sub = bn & 3;
      if (sub < 3) {
        const int rr = tid & 127, hh = tid >> 7;
        float v[64];
#pragma unroll
        for (int j = 0; j < 64; ++j) v[j] = sC[rr * SCS + hh * 64 + j];
        if (mixer == 1) {
          float ss = 0.f;
#pragma unroll
          for (int j = 0; j < 64; ++j) ss += v[j] * v[j];
          const float rn = rsqrtf(ss * (1.f / 64.f) + EPS);
          const float* gn = (sub < 2 ? P.in[I_BQN] : P.in[I_BKN]) + l * 64;
#pragma unroll
          for (int j = 0; j < 64; ++j) v[j] = v[j] * rn * gn[j];
        }
        if (lat) rope2d<16>(v, pos0 + rr - CTX);
        bfu* dst;
        if (sub < 2) {
#pragma unroll
          for (int j = 0; j < 64; ++j) v[j] *= 0.125f;
          const int hq = sub * 2 + hh;
          dst = (bfu*)(P.ws + (mixer ? OFF_QB : OFF_QA)) + ((size_t)(b * 4 + hq) * SA + pos0 + rr) * 64;
        } else {
          dst = (bfu*)(P.ws + (mixer ? OFF_KB : OFF_KA)) + ((size_t)(b * 2 + hh) * SA + pos0 + rr) * 64;
        }
        store_row_bf16_64(dst, v);
      } else {
        const int col = tid & 127, half = tid >> 7, kvh = col >> 6, d = col & 63;
        bfu* dstT = (bfu*)(P.ws + (mixer ? OFF_VTB : OFF_VTA)) + ((size_t)(b * 2 + kvh) * 64 + d) * SA + pos0;
        write_col_T(sC, col, half, dstT, 1.f, nullptr);
      }
    } else if (bn < 12) {
      if (bn < 10) write_raw_rows(sC, (bfu*)(P.ws + OFF_CQ), 256, (bn - 8) * 128, grow0);
      else if (bn == 10) write_raw_rows(sC, (bfu*)(P.ws + OFF_CKV), 128, 0, grow0);
      else if (tid < 128) {
        const int rr = tid;
        float v[32];
#pragma unroll
        for (int j = 0; j < 32; ++j) v[j] = sC[rr * SCS + j];
        if (lat) rope2d<8>(v, pos0 + rr - CTX);
        u32x4 o[4];
#pragma unroll
        for (int c = 0; c < 4; ++c) { o[c][0] = pack2(v[c * 8], v[c * 8 + 1]); o[c][1] = pack2(v[c * 8 + 2], v[c * 8 + 3]); o[c][2] = pack2(v[c * 8 + 4], v[c * 8 + 5]); o[c][3] = pack2(v[c * 8 + 6], v[c * 8 + 7]); }
#pragma unroll
        for (int hd = 0; hd < 4; ++hd) {
          bfu* dst = (bfu*)(P.ws + OFF_KC) + ((size_t)(b * 4 + hd) * SA + pos0 + rr) * 96 + 64;
#pragma unroll
          for (int c = 0; c < 4; ++c) *(u32x4*)(dst + c * 8) = o[c];
        }
      }
    } else {
      if (bn < 14) write_raw_rows(sC, (bfu*)(P.ws + OFF_Z), 256, (bn - 12) * 128, grow0);
      else if (bn < 20) write_raw_rows(sC, (bfu*)(P.ws + OFF_XBC), 768, (bn - 14) * 128, grow0);
      else if (tid < 8) {
        const int j = tid;
        const float bias = P.in[I_DTB][l * 8 + j];
        const float a_neg = -__expf(P.in[I_ALOG][l * 8 + j]);
        float* DT = (float*)(P.ws + OFF_DT); float* CS = (float*)(P.ws + OFF_CS);
        float run = 0.f;
        for (int rr = 0; rr < 128; ++rr) {
          const float x = sC[rr * SCS + j] + bias;
          const float dt = fmaxf(x, 0.f) + log1pf(__expf(-fabsf(x)));
          run += dt * a_neg;
          DT[(size_t)(grow0 + rr) * 8 + j] = dt; CS[(size_t)(grow0 + rr) * 8 + j] = run;
        }
      }
    }
    __syncthreads();
  }
}

DI void mla_uq_tile(const Params& P, int bm, int hd, char* lds) {
  const bfu* A = (const bfu*)(P.ws + OFF_CQ);
  const bfu* Wt = (const bfu*)(P.ws + OFF_W) + W_UQ;
  float* sC = (float*)lds; float* sR = sC + 128 * SCS;
  const int tid = threadIdx.x;
  f32x16 acc[2][2];
  gemm_mainloop(A, 256, Wt, 256, bm, hd, 0, nullptr, lds, acc);
  stage_acc(sC, acc);
  const int grow0 = bm * 128;
  {
    const int rr = tid >> 1, part = tid & 1;
    const u32x4* src = (const u32x4*)(A + (size_t)(grow0 + rr) * 256 + part * 128);
    float ss = 0.f;
#pragma unroll
    for (int c = 0; c < 16; ++c) { u32x4 u = src[c];
#pragma unroll
      for (int j = 0; j < 4; ++j) { float a = bflo(u[j]), bb = bfhi(u[j]); ss += a * a + bb * bb; } }
    ss += __shfl_xor(ss, 1);
    if (part == 0) sR[rr] = rsqrtf(ss * (1.f / 256.f) + EPS);
  }
  __syncthreads();
  if (tid < 128) {
    const int rr = tid;
    const bool lat = grow0 < TL;
    const int b = row_b(grow0), pos = row_pos(grow0) + rr;
    const float rs = sR[rr];
    const float qs = rs * 0.10206207261596575f;
    bfu* dst = (bfu*)(P.ws + OFF_QC) + ((size_t)(b * 4 + hd) * SA + pos) * 96;
    float v[64];
#pragma unroll
    for (int j = 0; j < 64; ++j) v[j] = sC[rr * SCS + j] * qs;
    store_row_bf16_64(dst, v);
    float w[32];
#pragma unroll
    for (int j = 0; j < 32; ++j) w[j] = sC[rr * SCS + 64 + j] * qs;
    if (lat) rope2d<8>(w, pos - CTX);
#pragma unroll
    for (int c = 0; c < 4; ++c) {
      u32x4 o; o[0] = pack2(w[c * 8], w[c * 8 + 1]); o[1] = pack2(w[c * 8 + 2], w[c * 8 + 3]); o[2] = pack2(w[c * 8 + 4], w[c * 8 + 5]); o[3] = pack2(w[c * 8 + 6], w[c * 8 + 7]);
      *(u32x4*)(dst + 64 + c * 8) = o;
    }
  }
  __syncthreads();
}

DI void mla_ukv_tile(const Params& P, int bm, int hd, char* lds) {
  const bfu* A = (const bfu*)(P.ws + OFF_CKV);
  const bfu* Wt = (const bfu*)(P.ws + OFF_W) + W_UKV;
  float* sC = (float*)lds; float* sR = sC + 128 * SCS;
  const int tid = threadIdx.x;
  f32x16 acc[2][2];
  gemm_mainloop(A, 128, Wt, 128, bm, hd, 0, nullptr, lds, acc);
  stage_acc(sC, acc);
  const int grow0 = bm * 128;
  {
    const int rr = tid >> 1, part = tid & 1;
    const u32x4* src = (const u32x4*)(A + (size_t)(grow0 + rr) * 128 + part * 64);
    float ss = 0.f;
#pragma unroll
    for (int c = 0; c < 8; ++c) { u32x4 u = src[c];
#pragma unroll
      for (int j = 0; j < 4; ++j) { float a = bflo(u[j]), bb = bfhi(u[j]); ss += a * a + bb * bb; } }
    ss += __shfl_xor(ss, 1);
    if (part == 0) sR[rr] = rsqrtf(ss * (1.f / 128.f) + EPS);
  }
  __syncthreads();
  const int b = row_b(grow0), pos0 = row_pos(grow0);
  if (tid < 128) {
    const int rr = tid;
    const float rs = sR[rr];
    float v[64];
#pragma unroll
    for (int j = 0; j < 64; ++j) v[j] = sC[rr * SCS + j] * rs;
    store_row_bf16_64((bfu*)(P.ws + OFF_KC) + ((size_t)(b * 4 + hd) * SA + pos0 + rr) * 96, v);
  } else {
    const int q = tid - 128, d = q & 63, half = q >> 6;
    bfu* dstT = (bfu*)(P.ws + OFF_VTC) + ((size_t)(b * 4 + hd) * 64 + d) * SA + pos0;
    write_col_T(sC, 64 + d, half, dstT, 1.f, sR);
  }
  __syncthreads();
}

DI void conv_prep_tile(const Params& P, int l, int rt, int ct, char* lds) {
  float* sIn = (float*)lds;
  const int tid = threadIdx.x;
  const int grow0 = rt * 128;
  const bool lat = grow0 < TL;
  const int b = row_b(grow0), pos0 = row_pos(grow0);
  const int seg_lo = lat ? b * SEQ : TL + b * CTX, seg_hi = seg_lo + (lat ? SEQ : CTX);
  const bfu* X = (const bfu*)(P.ws + OFF_XBC);
  for (int idx = tid; idx < 132 * 16; idx += 256) {
    const int rr = idx >> 4, c8 = idx & 15;
    const int grow = grow0 - 2 + rr;
    u32x4 u = {0u, 0u, 0u, 0u};
    if (grow >= seg_lo && grow < seg_hi) u = *(const u32x4*)(X + (size_t)grow * 768 + ct * 128 + c8 * 8);
    float* d = sIn + rr * 128 + c8 * 8;
#pragma unroll
    for (int j = 0; j < 4; ++j) { d[2 * j] = bflo(u[j]); d[2 * j + 1] = bfhi(u[j]); }
  }
  __syncthreads();
  const int cc = tid & 127, half = tid >> 7, ch = ct * 128 + cc;
  float w[5];
#pragma unroll
  for (int k = 0; k < 5; ++k) w[k] = P.in[I_CONVW][(size_t)l * 5 * 768 + k * 768 + ch];
  const float bias = P.in[I_CONVB][l * 768 + ch];
  bfu* dT = nullptr; bfu* dR = nullptr;
  if (ct < 2) { const int hd = ct * 2 + (cc >> 6), p = cc & 63; dT = (bfu*)(P.ws + OFF_XT) + ((size_t)(b * 4 + hd) * 64 + p) * SA + pos0 + half * 64; }
  else if (ct < 4) { const int g = ct - 2; dT = (bfu*)(P.ws + OFF_BT) + ((size_t)(b * 2 + g) * 128 + cc) * SA + pos0 + half * 64;
                     dR = (bfu*)(P.ws + OFF_BM) + ((size_t)(b * 2 + g) * SA + pos0 + half * 64) * 128 + cc; }
  else { const int g = ct - 4; dR = (bfu*)(P.ws + OFF_CM) + ((size_t)(b * 2 + g) * SA + pos0 + half * 64) * 128 + cc; }
  for (int c = 0; c < 8; ++c) {
    float in[12];
#pragma unroll
    for (int j = 0; j < 12; ++j) in[j] = sIn[(half * 64 + c * 8 + j) * 128 + cc];
    float o[8];
#pragma unroll
    for (int j = 0; j < 8; ++j) {
      float s = bias;
#pragma unroll
      for (int k = 0; k < 5; ++k) s += w[k] * in[j + k];
      o[j] = silu_f(s);
    }
    if (dT) { u32x4 q; q[0] = pack2(o[0], o[1]); q[1] = pack2(o[2], o[3]); q[2] = pack2(o[4], o[5]); q[3] = pack2(o[6], o[7]); *(u32x4*)(dT + c * 8) = q; }
    if (dR) {
#pragma unroll
      for (int j = 0; j < 8; ++j) dR[(size_t)(c * 8 + j) * 128] = f2bf(o[j]);
    }
  }
  __syncthreads();
}

DI void phase_mla_conv(const Params& P, int l, char* lds) {
  const int n_uq = 144 * 4, n_ukv = 144 * 4, n_cv = 144 * 6;
  const int total = n_uq + n_ukv + n_cv;
  for (int it = blockIdx.x; it < total; it += gridDim.x) {
    if (it < n_uq) mla_uq_tile(P, it >> 2, it & 3, lds);
    else if (it < n_uq + n_ukv) { const int id = it - n_uq; mla_ukv_tile(P, id >> 2, id & 3, lds); }
    else { const int id = it - n_uq - n_ukv; conv_prep_tile(P, l, id / 6, id % 6, lds); }
  }
}

template <int DQK>
DI void attn_item(const bfu* __restrict__ Qp, const bfu* __restrict__ Kp, const bfu* __restrict__ VTp, int n1, int p1, int n2, int p2,
                  bool masked, int q0lat, bool has_sink, float sink, bfu* __restrict__ Op, char* lds) {
  constexpr int KS = DQK + 8, NKS = DQK / 16, VS = 72;
  bfu* sK = (bfu*)lds;
  bfu* sV = sK + 64 * KS;
  const int tid = threadIdx.x, lane = tid & 63, wave = tid >> 6, r = lane & 31, h = lane >> 5;
  bf16x8 qf[NKS];
  const bfu* qrow = Qp + (size_t)(wave * 32 + r) * DQK;
#pragma unroll
  for (int s = 0; s < NKS; ++s) qf[s] = *(const bf16x8*)(qrow + s * 16 + h * 8);
  f32x16 o[2];
#pragma unroll
  for (int i = 0; i < 16; ++i) { o[0][i] = 0.f; o[1][i] = 0.f; }
  float m = has_sink ? sink : -INFINITY;
  float lsum = (has_sink && h == 0) ? 1.f : 0.f;
  const int qpos = q0lat + wave * 32 + r;
  const int nt = n1 + n2;
  for (int tt = 0; tt < nt; ++tt) {
    const int pos = tt < n1 ? p1 + tt * 64 : p2 + (tt - n1) * 64;
    __syncthreads();
    for (int c = tid; c < 64 * (DQK / 8); c += 256) {
      const int kr = c / (DQK / 8), kc = c % (DQK / 8);
      *(u32x4*)(sK + kr * KS + kc * 8) = *(const u32x4*)(Kp + (size_t)(pos + kr) * DQK + kc * 8);
    }
    for (int c = tid; c < 512; c += 256) {
      const int d = c >> 3, kc = c & 7;
      *(u32x4*)(sV + d * VS + kc * 8) = *(const u32x4*)(VTp + (size_t)d * SA + pos + kc * 8);
    }
    __syncthreads();
    f32x16 s[2];
#pragma unroll
    for (int i = 0; i < 16; ++i) { s[0][i] = 0.f; s[1][i] = 0.f; }
#pragma unroll
    for (int mt = 0; mt < 2; ++mt)
#pragma unroll
      for (int ks = 0; ks < NKS; ++ks) {
        bf16x8 a = *(const bf16x8*)(sK + (mt * 32 + r) * KS + ks * 16 + h * 8);
        s[mt] = MFMA(a, qf[ks], s[mt]);
      }
    if (masked && tt >= n1) {
      const int kbase = pos - CTX;
#pragma unroll
      for (int mt = 0; mt < 2; ++mt)
#pragma unroll
        for (int i = 0; i < 16; ++i) {
          const int kp = kbase + mt * 32 + crow(i, h);
          const int dlt = qpos - kp;
          if (dlt > 128 || dlt < -128) s[mt][i] = -INFINITY;
        }
    }
    float mx = s[0][0];
#pragma unroll
    for (int i = 1; i < 16; ++i) mx = fmaxf(mx, s[0][i]);
#pragma unroll
    for (int i = 0; i < 16; ++i) mx = fmaxf(mx, s[1][i]);
    mx = fmaxf(mx, __shfl_xor(mx, 32));
    const float mn = fmaxf(m, mx);
    const float alpha = __expf(m - mn);
    float rs = 0.f;
#pragma unroll
    for (int mt = 0; mt < 2; ++mt)
#pragma unroll
      for (int i = 0; i < 16; ++i) { const float p = __expf(s[mt][i] - mn); s[mt][i] = p; rs += p; }
    lsum = lsum * alpha + rs;
    m = mn;
#pragma unroll
    for (int i = 0; i < 16; ++i) { o[0][i] *= alpha; o[1][i] *= alpha; }
#pragma unroll
    for (int s2 = 0; s2 < 4; ++s2) {
      const int mt = s2 >> 1, ss = s2 & 1;
      u32x4 pb;
#pragma unroll
      for (int j = 0; j < 4; ++j) pb[j] = pack2(s[mt][8 * ss + 2 * j], s[mt][8 * ss + 2 * j + 1]);
      const bf16x8 bfrag = __builtin_bit_cast(bf16x8, pb);
#pragma unroll
      for (int mt2 = 0; mt2 < 2; ++mt2) {
        const bfu* vp = sV + (mt2 * 32 + r) * VS + 32 * mt + 16 * ss + 4 * h;
        bf16x4 lo = *(const bf16x4*)vp, hi = *(const bf16x4*)(vp + 8);
        const bf16x8 a = __builtin_shufflevector(lo, hi, 0, 1, 2, 3, 4, 5, 6, 7);
        o[mt2] = MFMA(a, bfrag, o[mt2]);
      }
    }
  }
  const float ltot = lsum + __shfl_xor(lsum, 32);
  const float inv = 1.f / ltot;
  bfu* orow = Op + (size_t)(wave * 32 + r) * D;
#pragma unroll
  for (int mt2 = 0; mt2 < 2; ++mt2)
#pragma unroll
    for (int g = 0; g < 4; ++g) {
      u32x2 q; q[0] = pack2(o[mt2][4 * g] * inv, o[mt2][4 * g + 1] * inv); q[1] = pack2(o[mt2][4 * g + 2] * inv, o[mt2][4 * g + 3] * inv);
      *(u32x2*)(orow + mt2 * 32 + 8 * g + 4 * h) = q;
    }
}

DI int chunk_row0(int b, int oc) { return oc < 2 ? TL + b * CTX + oc * 128 : b * SEQ + (oc - 2) * 128; }

DI void ssd_state_item(const Params& P, int l, int id, char* lds) {
  const int hd = id & 3, oc = (id >> 2) % NCH, dir = (id / (4 * NCH)) & 1, b = id / (8 * NCH);
  const int tid = threadIdx.x, lane = tid & 63, wave = tid >> 6, r = lane & 31, h = lane >> 5;
  bfu* sX = (bfu*)lds;
  float* sW = (float*)(lds + 64 * 136 * 2);
  const int grow0 = chunk_row0(b, oc), pos0 = oc * 128, g = hd >> 1, col = dir * 4 + hd;
  const float* DT = (const float*)(P.ws + OFF_DT); const float* CS = (const float*)(P.ws + OFF_CS);
  __syncthreads();
  if (tid < 128) {
    const float cs = CS[(size_t)(grow0 + tid) * 8 + col], dt = DT[(size_t)(grow0 + tid) * 8 + col];
    const float tot = CS[(size_t)(grow0 + 127) * 8 + col];
    const float a_neg = -__expf(P.in[I_ALOG][l * 8 + col]);
    sW[tid] = dir == 0 ? dt * __expf(tot - cs) : dt * __expf(cs - dt * a_neg);
  }
  __syncthreads();
  const bfu* XT = (const bfu*)(P.ws + OFF_XT) + ((size_t)(b * 4 + hd) * 64) * SA + pos0;
#pragma unroll
  for (int i = 0; i < 4; ++i) {
    const int c = tid + 256 * i, p = c >> 4, j8 = (c & 15) * 8;
    u32x4 u = *(const u32x4*)(XT + (size_t)p * SA + j8);
    u32x4 q;
#pragma unroll
    for (int j = 0; j < 4; ++j) q[j] = pack2(bflo(u[j]) * sW[j8 + 2 * j], bfhi(u[j]) * sW[j8 + 2 * j + 1]);
    *(u32x4*)(sX + p * 136 + j8) = q;
  }
  __syncthreads();
  f32x16 acc[2];
#pragma unroll
  for (int i = 0; i < 16; ++i) { acc[0][i] = 0.f; acc[1][i] = 0.f; }
  const bfu* BT = (const bfu*)(P.ws + OFF_BT) + ((size_t)(b * 2 + g) * 128 + wave * 32 + r) * SA + pos0 + h * 8;
#pragma unroll
  for (int s = 0; s < 8; ++s) {
    const bf16x8 bb = *(const bf16x8*)(BT + s * 16);
#pragma unroll
    for (int mt = 0; mt < 2; ++mt) {
      const bf16x8 a = *(const bf16x8*)(sX + (mt * 32 + r) * 136 + s * 16 + h * 8);
      acc[mt] = MFMA(a, bb, acc[mt]);
    }
  }
  bfu* ST = (bfu*)(P.ws + OFF_ST) + ((size_t)((b * 2 + dir) * NCH + oc) * 4 + hd) * 8192;
#pragma unroll
  for (int mt = 0; mt < 2; ++mt)
#pragma unroll
    for (int i = 0; i < 16; ++i) ST[(mt * 32 + crow(i, h)) * 128 + wave * 32 + r] = f2bf(acc[mt][i]);
}

DI void phase_scan(const Params& P) {
  const float* CS = (const float*)(P.ws + OFF_CS);
  const int total = NB * 2 * 4 * 1024;
  for (int u = blockIdx.x * 256 + threadIdx.x; u < total; u += gridDim.x * 256) {
    const int e8 = u & 1023, hd = (u >> 10) & 3, dir = (u >> 12) & 1, b = u >> 13;
    float hs[8];
#pragma unroll
    for (int j = 0; j < 8; ++j) hs[j] = 0.f;
    for (int step = 0; step < NCH; ++step) {
      const int oc = dir == 0 ? step : (step < 2 ? 1 - step : 19 - step);
      bfu* p = (bfu*)(P.ws + OFF_ST) + ((size_t)((b * 2 + dir) * NCH + oc) * 4 + hd) * 8192 + e8 * 8;
      const u32x4 st = *(const u32x4*)p;
      u32x4 o;
#pragma unroll
      for (int j = 0; j < 4; ++j) o[j] = pack2(hs[2 * j], hs[2 * j + 1]);
      *(u32x4*)p = o;
      const float dec = __expf(CS[(size_t)(chunk_row0(b, oc) + 127) * 8 + dir * 4 + hd]);
#pragma unroll
      for (int j = 0; j < 4; ++j) { hs[2 * j] = dec * hs[2 * j] + bflo(st[j]); hs[2 * j + 1] = dec * hs[2 * j + 1] + bfhi(st[j]); }
    }
  }
}

DI void ssd_y_item(const Params& P, int l, int b, int oc, int hd, char* lds) {
  const int tid = threadIdx.x, lane = tid & 63, wave = tid >> 6, r = lane & 31, h = lane >> 5;
  bfu* sB = (bfu*)lds;
  bfu* sX = sB + 128 * 136;
  float* sF = (float*)(sX + 64 * 136);
  const int grow0 = chunk_row0(b, oc), pos0 = oc * 128, g = hd >> 1;
  const float* DT = (const float*)(P.ws + OFF_DT); const float* CS = (const float*)(P.ws + OFF_CS);
  const float anb = -__expf(P.in[I_ALOG][l * 8 + 4 + hd]);
  __syncthreads();
  if (tid < 128) {
    const size_t o = (size_t)(grow0 + tid) * 8;
    const float csf = CS[o + hd], dtf = DT[o + hd], csb = CS[o + 4 + hd], dtb = DT[o + 4 + hd];
    sF[tid] = csf; sF[128 + tid] = csb - dtb * anb; sF[256 + tid] = dtf; sF[384 + tid] = dtb;
  }
  const float totb = CS[(size_t)(grow0 + 127) * 8 + 4 + hd];
  {
    const bfu* BMp = (const bfu*)(P.ws + OFF_BM) + ((size_t)(b * 2 + g) * SA + pos0) * 128;
#pragma unroll
    for (int i = 0; i < 8; ++i) { const int c = tid + 256 * i, j = c >> 4, n8 = (c & 15) * 8; *(u32x4*)(sB + j * 136 + n8) = *(const u32x4*)(BMp + (size_t)j * 128 + n8); }
    const bfu* XT = (const bfu*)(P.ws + OFF_XT) + ((size_t)(b * 4 + hd) * 64) * SA + pos0;
#pragma unroll
    for (int i = 0; i < 4; ++i) { const int c = tid + 256 * i, p = c >> 4, j8 = (c & 15) * 8; *(u32x4*)(sX + p * 136 + j8) = *(const u32x4*)(XT + (size_t)p * SA + j8); }
  }
  __syncthreads();
  const int qi = wave * 32 + r;
  bf16x8 cf[8];
  {
    const bfu* CMp = (const bfu*)(P.ws + OFF_CM) + ((size_t)(b * 2 + g) * SA + pos0 + qi) * 128 + h * 8;
#pragma unroll
    for (int s = 0; s < 8; ++s) cf[s] = *(const bf16x8*)(CMp + s * 16);
  }
  f32x16 g4[4];
#pragma unroll
  for (int mt = 0; mt < 4; ++mt) {
#pragma unroll
    for (int i = 0; i < 16; ++i) g4[mt][i] = 0.f;
#pragma unroll
    for (int s = 0; s < 8; ++s) {
      const bf16x8 a = *(const bf16x8*)(sB + (mt * 32 + r) * 136 + s * 16 + h * 8);
      g4[mt] = MFMA(a, cf[s], g4[mt]);
    }
  }
  const float my_csf = sF[qi], my_eb = sF[128 + qi];
#pragma unroll
  for (int mt = 0; mt < 4; ++mt)
#pragma unroll
    for (int i = 0; i < 16; ++i) {
      const int j = mt * 32 + crow(i, h);
      float f = 0.f;
      if (j <= qi) f += __expf(my_csf - sF[j]) * sF[256 + j];
      if (j >= qi) f += __expf(sF[128 + j] - my_eb) * sF[384 + j];
      g4[mt][i] *= f;
    }
  f32x16 y[2];
#pragma unroll
  for (int i = 0; i < 16; ++i) { y[0][i] = 0.f; y[1][i] = 0.f; }
#pragma unroll
  for (int s2 = 0; s2 < 8; ++s2) {
    const int mt = s2 >> 1, ss = s2 & 1;
    u32x4 pb;
#pragma unroll
    for (int j = 0; j < 4; ++j) pb[j] = pack2(g4[mt][8 * ss + 2 * j], g4[mt][8 * ss + 2 * j + 1]);
    const bf16x8 bfrag = __builtin_bit_cast(bf16x8, pb);
#pragma unroll
    for (int mt2 = 0; mt2 < 2; ++mt2) {
      const bfu* vp = sX + (mt2 * 32 + r) * 136 + 32 * mt + 16 * ss + 4 * h;
      bf16x4 lo = *(const bf16x4*)vp, hi = *(const bf16x4*)(vp + 8);
      const bf16x8 a = __builtin_shufflevector(lo, hi, 0, 1, 2, 3, 4, 5, 6, 7);
      y[mt2] = MFMA(a, bfrag, y[mt2]);
    }
  }
#pragma unroll
  for (int dir = 0; dir < 2; ++dir) {
    f32x16 tmp[2];
#pragma unroll
    for (int i = 0; i < 16; ++i) { tmp[0][i] = 0.f; tmp[1][i] = 0.f; }
    const bfu* hin = (const bfu*)(P.ws + OFF_ST) + ((size_t)((b * 2 + dir) * NCH + oc) * 4 + hd) * 8192 + h * 8;
#pragma unroll
    for (int s = 0; s < 8; ++s)
#pragma unroll
      for (int mt2 = 0; mt2 < 2; ++mt2) {
        const bf16x8 a = *(const bf16x8*)(hin + (mt2 * 32 + r) * 128 + s * 16);
        tmp[mt2] = MFMA(a, cf[s], tmp[mt2]);
      }
    const float sc = dir == 0 ? __expf(my_csf) : __expf(totb - my_eb);
#pragma unroll
    for (int i = 0; i < 16; ++i) { y[0][i] += sc * tmp[0][i]; y[1][i] += sc * tmp[1][i]; }
  }
  const float skip = P.in[I_SKIP][l * 4 + hd];
  const int grow = grow0 + qi;
  const bfu* Zr = (const bfu*)(P.ws + OFF_Z) + (size_t)grow * 256 + hd * 64;
  bfu* Or = (bfu*)(P.ws + OFF_NBUF) + (size_t)grow * D + 768 + hd * 64;
  float ss = 0.f;
#pragma unroll
  for (int mt2 = 0; mt2 < 2; ++mt2)
#pragma unroll
    for (int gq = 0; gq < 4; ++gq) {
      const int p0 = mt2 * 32 + 8 * gq + 4 * h;
      const u32x2 zz = *(const u32x2*)(Zr + p0);
      float u4[4];
#pragma unroll
      for (int j = 0; j < 4; ++j) {
        const float x = bf2f(sX[(p0 + j) * 136 + qi]);
        const float z = (j & 1) ? bfhi(zz[j >> 1]) : bflo(zz[j >> 1]);
        const float u = (y[mt2][4 * gq + j] + skip * x) * silu_f(z);
        u4[j] = u; ss += u * u;
      }
      u32x2 q; q[0] = pack2(u4[0], u4[1]); q[1] = pack2(u4[2], u4[3]);
      *(u32x2*)(Or + p0) = q;
    }
  ss += __shfl_xor(ss, 32);
  if (h == 0) atomicAdd((float*)(P.ws + OFF_ROWSS) + grow, ss);
}

DI void phase_ssd_y(const Params& P, int l, char* lds) {
  const int oc_lo = l == 0 ? 0 : 2, noc = NCH - oc_lo;
  const int total = NB * noc * 4;
  for (int it = blockIdx.x; it < total; it += gridDim.x) {
    const int hd = it & 3, oc = oc_lo + (it >> 2) % noc, b = (it >> 2) / noc;
    ssd_y_item(P, l, b, oc, hd, lds);
  }
}

DI void phase_attn(const Params& P, int l, char* lds) {
  const int nB = 512, nC = 512, nA = 512, nS = NB * 2 * NCH * 4, nX = l == 0 ? 192 : 0;
  const int total = nB + nC + nA + nS + nX;
  bfu* O = (bfu*)(P.ws + OFF_NBUF);
  for (int it = blockIdx.x; it < total; it += gridDim.x) {
    if (it < nB + nC + nA) {
      const int mixer = it < nB ? 1 : (it < nB + nC ? 2 : 0);
      const int id = it < nB ? it : (it < nB + nC ? it - nB : it - nB - nC);
      const int b = id >> 6, hq = (id >> 4) & 3, qb = id & 15;
      const int q0 = qb * 128;
      bfu* Op = O + (size_t)(b * SEQ + q0) * D + (mixer == 0 ? 0 : (mixer == 1 ? 256 : 512)) + hq * 64;
      if (mixer == 1) {
        const bfu* Qp = (const bfu*)(P.ws + OFF_QB) + ((size_t)(b * 4 + hq) * SA + CTX + q0) * 64;
        const bfu* Kp = (const bfu*)(P.ws + OFF_KB) + (size_t)(b * 2 + (hq >> 1)) * SA * 64;
        const bfu* Vp = (const bfu*)(P.ws + OFF_VTB) + (size_t)(b * 2 + (hq >> 1)) * 64 * SA;
        attn_item<64>(Qp, Kp, Vp, 36, 0, 0, 0, false, 0, false, 0.f, Op, lds);
      } else if (mixer == 2) {
        const bfu* Qp = (const bfu*)(P.ws + OFF_QC) + ((size_t)(b * 4 + hq) * SA + CTX + q0) * 96;
        const bfu* Kp = (const bfu*)(P.ws + OFF_KC) + (size_t)(b * 4 + hq) * SA * 96;
        const bfu* Vp = (const bfu*)(P.ws + OFF_VTC) + (size_t)(b * 4 + hq) * 64 * SA;
        attn_item<96>(Qp, Kp, Vp, 36, 0, 0, 0, false, 0, false, 0.f, Op, lds);
      } else {
        const bfu* Qp = (const bfu*)(P.ws + OFF_QA) + ((size_t)(b * 4 + hq) * SA + CTX + q0) * 64;
        const bfu* Kp = (const bfu*)(P.ws + OFF_KA) + (size_t)(b * 2 + (hq >> 1)) * SA * 64;
        const bfu* Vp = (const bfu*)(P.ws + OFF_VTA) + (size_t)(b * 2 + (hq >> 1)) * 64 * SA;
        const int lo = q0 - 128 < 0 ? 0 : q0 - 128, hi = q0 + 256 > SEQ ? SEQ : q0 + 256;
        attn_item<64>(Qp, Kp, Vp, 4, 0, (hi - lo) >> 6, CTX + lo, true, q0, true, P.in[I_SINK][l * 4 + hq], Op, lds);
      }
    } else if (it < nB + nC + nA + nS) {
      ssd_state_item(P, l, it - (nB + nC + nA), lds);
    } else {
      const int id = it - (nB + nC + nA + nS);
      const int mixer = id >> 6, b = (id >> 3) & 7, hq = (id >> 1) & 3, qb = id & 1;
      const int q0 = qb * 128;
      bfu* Op = O + (size_t)(TL + b * CTX + q0) * D + mixer * 256 + hq * 64;
      if (mixer == 2) {
        const bfu* Qp = (const bfu*)(P.ws + OFF_QC) + ((size_t)(b * 4 + hq) * SA + q0) * 96;
        const bfu* Kp = (const bfu*)(P.ws + OFF_KC) + (size_t)(b * 4 + hq) * SA * 96;
        const bfu* Vp = (const bfu*)(P.ws + OFF_VTC) + (size_t)(b * 4 + hq) * 64 * SA;
        attn_item<96>(Qp, Kp, Vp, 4, 0, 0, 0, false, 0, false, 0.f, Op, lds);
      } else {
        const bfu* Qp = (const bfu*)(P.ws + (mixer ? OFF_QB : OFF_QA)) + ((size_t)(b * 4 + hq) * SA + q0) * 64;
        const bfu* Kp = (const bfu*)(P.ws + (mixer ? OFF_KB : OFF_KA)) + (size_t)(b * 2 + (hq >> 1)) * SA * 64;
        const bfu* Vp = (const bfu*)(P.ws + (mixer ? OFF_VTB : OFF_VTA)) + (size_t)(b * 2 + (hq >> 1)) * 64 * SA;
        attn_item<64>(Qp, Kp, Vp, 4, 0, 0, 0, false, 0, mixer == 0, mixer == 0 ? P.in[I_SINK][l * 4 + hq] : 0.f, Op, lds);
      }
    }
  }
}


#define XB_TMO      128
#define XB_XCNT(j)  (256  + 64 * (j))
#define XB_XSUB(j)  (1280 + 64 * (j))
#define XB_XGEN(j)  (2304 + 64 * (j))
#define XB_TOP      3328
#define XB_TOPGEN   3392
#define XCD_BAR_WORDS 3456
#define XB_SPIN_CAP (1u << 18)
#define LAS __attribute__((address_space(3)))
DI unsigned xb_ld(unsigned* p)              { return __hip_atomic_load(p, __ATOMIC_RELAXED, __HIP_MEMORY_SCOPE_AGENT); }
DI unsigned xb_add(unsigned* p, unsigned v) { return __hip_atomic_fetch_add(p, v, __ATOMIC_RELAXED, __HIP_MEMORY_SCOPE_AGENT); }
DI unsigned xb_xcc_id() { return (unsigned)__builtin_amdgcn_s_getreg((3 << 11) | 20) & 0xFu; }
#define XB_SPIN(cond, bar) do { unsigned _sp = 0; while (cond) { __builtin_amdgcn_s_sleep(1); \
    if ((++_sp & 255u) == 0u) { if (xb_ld(&(bar)[XB_TMO])) break; if (_sp > XB_SPIN_CAP) { atomicAdd(&(bar)[XB_TMO], 1u); break; } } } } while (0)
struct XcdBarrier { unsigned* bar; unsigned x; volatile LAS unsigned* st; };
DI XcdBarrier xcd_barrier_post(unsigned* bar, volatile LAS unsigned* st) {
  XcdBarrier b; b.bar = bar; b.x = xb_xcc_id(); b.st = st;
  if (threadIdx.x == 0) (void)xb_add(&bar[XB_XCNT(b.x)], 1u);
  return b;
}
DI void xcd_barrier_complete(unsigned* bar, unsigned x, unsigned& nloc, unsigned& nx) {
  const unsigned G = gridDim.x * gridDim.y * gridDim.z;
  unsigned sum, cnt, mine, sp = 0u;
  for (;;) {
    sum = 0u; cnt = 0u; mine = 0u;
#pragma unroll
    for (unsigned j = 0; j < 16; ++j) { const unsigned c = xb_ld(&bar[XB_XCNT(j)]); sum += c; cnt += (c > 0u) ? 1u : 0u; mine = (j == x) ? c : mine; }
    if (sum == G) break;
    __builtin_amdgcn_s_sleep(1);
    if ((++sp & 255u) == 0u) { if (xb_ld(&bar[XB_TMO])) break; if (sp > XB_SPIN_CAP) { atomicAdd(&bar[XB_TMO], 1u); break; } }
  }
  nloc = mine > 0u ? mine : 1u; nx = cnt > 0u ? cnt : 1u;
}
DI void xcd_barrier(const XcdBarrier& b) {
  asm volatile("s_waitcnt vmcnt(0)" ::: "memory");
  __syncthreads();
  if (threadIdx.x == 0) {
    unsigned* bar = b.bar;
    __builtin_amdgcn_s_waitcnt(0);
    unsigned nloc = b.st[0], nx = b.st[1];
    if (nloc == 0u) { xcd_barrier_complete(bar, b.x, nloc, nx); b.st[0] = nloc; b.st[1] = nx; }
    const unsigned old = xb_add(&bar[XB_XSUB(b.x)], 1u);
    const unsigned gen = old / nloc;
    if (old + 1u == (gen + 1u) * nloc) {
      __builtin_amdgcn_fence(__ATOMIC_RELEASE, "agent");
      asm volatile("s_waitcnt vmcnt(0)" ::: "memory");
      const unsigned og = xb_add(&bar[XB_TOP], 1u);
      const unsigned tg = og / nx;
      if (og + 1u == (tg + 1u) * nx) xb_add(&bar[XB_TOPGEN], 1u);
      else XB_SPIN(xb_ld(&bar[XB_TOPGEN]) == tg, bar);
      __builtin_amdgcn_fence(__ATOMIC_ACQUIRE, "agent");
      xb_add(&bar[XB_XGEN(b.x)], 1u);
      asm volatile("s_waitcnt vmcnt(0)" ::: "memory");
    } else {
      XB_SPIN(xb_ld(&bar[XB_XGEN(b.x)]) == gen, bar);
      __builtin_amdgcn_fence(__ATOMIC_ACQUIRE, "agent");
      asm volatile("s_waitcnt vmcnt(0)" ::: "memory");
    }
  }
  __syncthreads();
}

constexpr int PH_PER_LAYER = 14;
constexpr int N_PHASES = 2 * PH_PER_LAYER + 1;

template <int L>
DI void run_layer(const Params& P, const XcdBarrier& bar, char* lds) {
  const bfu* Wb = (const bfu*)(P.ws + OFF_W);
  const float* hc = (const float*)(P.ws + OFF_HC);
  constexpr int M2 = L == 0 ? T : TL;
  const float* s_lat = L == 0 ? P.in[I_X] : P.out;
  const float* s_ctx = L == 0 ? P.in[I_CTX] : hc;
  const int lo = P.ph_lo, hi = P.ph_hi;
#ifndef REP_MASK
#define REP_MASK 0
#endif
#define PH(k, body) { const int ph_ = L * PH_PER_LAYER + (k); if (lo <= ph_ && ph_ < hi) { body; if ((REP_MASK >> (k)) & 1) { xcd_barrier(bar); body; } if (ph_ + 1 < hi) xcd_barrier(bar); } }
  PH(0, phase_convert(P, L, lds))
  PH(1, phase_norm(P, s_lat, s_ctx, P.in[I_F1N] + L * D, 0, 1, T, false))
  PH(2, phase_gemm_swiglu(P, Wb + W_WI1, T, lds))
  PH(3, phase_gemm_resid(P, (const bfu*)(P.ws + OFF_ACT), FFN, Wb + W_WO1, T, 2, 0.5f, s_lat, s_ctx, 0, nullptr, lds))
  PH(4, phase_norm(P, P.out, hc, P.in[I_MIXN] + L * D, 3, 4, T, true))
  PH(5, phase_gemm_win(P, L, lds))
  PH(6, phase_mla_conv(P, L, lds))
  PH(7, phase_attn(P, L, lds))
  PH(8, phase_scan(P))
  PH(9, phase_ssd_y(P, L, lds))
  PH(10, phase_gemm_resid(P, (const bfu*)(P.ws + OFF_NBUF), D, Wb + W_WOUT, M2, 5, 1.0f, P.out, hc, 12, (const float*)(P.ws + OFF_ROWSS), lds))
  PH(11, phase_norm(P, P.out, hc, P.in[I_F2N] + L * D, 6, 7, M2, false))
  PH(12, phase_gemm_swiglu(P, Wb + W_WI2, M2, lds))
  PH(13, phase_gemm_resid(P, (const bfu*)(P.ws + OFF_ACT), FFN, Wb + W_WO2, M2, 8, 0.5f, P.out, hc, 0, nullptr, lds))
#undef PH
}

__global__ void __launch_bounds__(256, 2) fwd_kernel(Params P) {
  extern __shared__ __attribute__((aligned(16))) char lds[];
  __shared__ uint4 xb_words;
  cg::grid_group grid = cg::this_grid();
  if (threadIdx.x == 0) xb_words = make_uint4(0u, 0u, 0u, 0u);
  __syncthreads();
  XcdBarrier bar = xcd_barrier_post((unsigned*)(P.ws + OFF_BAR), (volatile LAS unsigned*)&xb_words);
  if (P.ph_hi > 1000) grid.sync();
  run_layer<0>(P, bar, lds);
  run_layer<1>(P, bar, lds);
  if (P.ph_lo <= N_PHASES - 1 && N_PHASES - 1 < P.ph_hi) phase_final(P);
}

extern "C" void kernel_launch(void* const* d_in, const int* in_sizes, int n_in, void* d_out, int out_size, void* d_ws, size_t ws_size,
                              hipStream_t stream) {
  static int grid_blocks = 0;
  if (grid_blocks == 0) {
    if (ws_size < OFF_END) { fprintf(stderr, "kernel_launch: workspace too small: %zu < %zu\n", ws_size, (size_t)OFF_END); grid_blocks = -1; return; }
    int dev = 0, cus = 0, per_cu = 0;
    (void)hipGetDevice(&dev);
    (void)hipDeviceGetAttribute(&cus, hipDeviceAttributeMultiprocessorCount, dev);
    if (hipFuncSetAttribute((const void*)fwd_kernel, hipFuncAttributeMaxDynamicSharedMemorySize, LDS_BYTES) != hipSuccess) {
      fprintf(stderr, "kernel_launch: hipFuncSetAttribute failed\n"); grid_blocks = -1; return; }
    (void)hipOccupancyMaxActiveBlocksPerMultiprocessor(&per_cu, (const void*)fwd_kernel, 256, LDS_BYTES);
    if (per_cu < 1) { fprintf(stderr, "kernel_launch: occupancy query returned %d\n", per_cu); grid_blocks = -1; return; }
    if (per_cu > 2) per_cu = 2;
    grid_blocks = cus * per_cu;
    fprintf(stderr, "kernel_launch: grid %d (%d per CU), ws need %zu have %zu\n", grid_blocks, per_cu, (size_t)OFF_END, ws_size);
  }
  if (grid_blocks < 0) return;
  Params p{};
  for (int i = 0; i < 29; ++i) p.in[i] = (const float*)d_in[i];
  p.out = (float*)d_out; p.ws = (unsigned char*)d_ws;
#if MULTI_LAUNCH
  for (int ph = 0; ph < N_PHASES; ++ph) {
    (void)hipMemsetAsync(d_ws, 0, 16384, stream);
    p.ph_lo = ph; p.ph_hi = ph + 1;
    void* args[] = {&p};
    (void)hipLaunchCooperativeKernel((const void*)fwd_kernel, dim3(grid_blocks), dim3(256), args, LDS_BYTES, stream);
  }
#else
  (void)hipMemsetAsync(d_ws, 0, 16384, stream);
  p.ph_lo = 0; p.ph_hi = N_PHASES;
  void* args[] = {&p};
  hipError_t e = hipLaunchCooperativeKernel((const void*)fwd_kernel, dim3(grid_blocks), dim3(256), args, LDS_BYTES, stream);
  if (e != hipSuccess) fprintf(stderr, "cooperative launch failed: %s (grid %d)\n", hipGetErrorString(e), grid_blocks);
#endif
}
```

```cpp
#include <hip/hip_runtime.h>
#include <hip/hip_cooperative_groups.h>
#include <cstdio>
namespace cg = cooperative_groups;

#ifndef TIMEMASK
#define TIMEMASK 0
#endif
#ifndef TIMESCALE
#define TIMESCALE 1e-7f
#endif
#ifndef MULTI_LAUNCH
#define MULTI_LAUNCH 0
#endif

#define DI __device__ __forceinline__
typedef unsigned short bfu;
typedef __attribute__((ext_vector_type(8))) short bf16x8;
typedef __attribute__((ext_vector_type(4))) short bf16x4;
typedef __attribute__((ext_vector_type(16))) float f32x16;
typedef __attribute__((ext_vector_type(2))) __bf16 bf2_t;
typedef __attribute__((ext_vector_type(2))) float f2_t;
typedef __attribute__((ext_vector_type(4))) unsigned u32x4;
typedef __attribute__((ext_vector_type(2))) unsigned u32x2;

#define MFMA(a, b, c) __builtin_amdgcn_mfma_f32_32x32x16_bf16((a), (b), (c), 0, 0, 0)

DI unsigned pack2(float a, float b) { f2_t v = {a, b}; return __builtin_bit_cast(unsigned, __builtin_convertvector(v, bf2_t)); }
DI bfu f2bf(float a) { return (bfu)(pack2(a, 0.f) & 0xffffu); }
DI float bf2f(bfu v) { return __uint_as_float(((unsigned)v) << 16); }
DI float bflo(unsigned u) { return __uint_as_float(u << 16); }
DI float bfhi(unsigned u) { return __uint_as_float(u & 0xffff0000u); }
DI int crow(int reg, int h) { return (reg & 3) + 8 * (reg >> 2) + 4 * h; }
DI float silu_f(float x) { return x * __builtin_amdgcn_rcpf(1.f + __builtin_amdgcn_exp2f(-1.4426950408889634f * x)); }

constexpr int D = 1024, SEQ = 2048, CTX = 256, NB = 8, FFN = 2816;
constexpr int TL = NB * SEQ;
constexpr int TC = NB * CTX;
constexpr int T = TL + TC;
constexpr int SA = CTX + SEQ;
constexpr int NWIN = 2688;
constexpr int NMOD = 9 * D;
constexpr float EPS = 1e-6f;
constexpr int NCH = 18;

constexpr size_t al(size_t x) { return (x + 255) & ~(size_t)255; }
constexpr size_t E_WI = (size_t)2 * FFN * D, E_WO = (size_t)D * FFN, E_WIN = (size_t)NWIN * D, E_WOUT = (size_t)D * D;
constexpr size_t E_UQ = 512 * 256, E_UKV = 512 * 128;
constexpr size_t W_WI1 = 0, W_WO1 = W_WI1 + E_WI, W_WIN = W_WO1 + E_WO, W_WOUT = W_WIN + E_WIN, W_WI2 = W_WOUT + E_WOUT,
                 W_WO2 = W_WI2 + E_WI, W_UQ = W_WO2 + E_WO, W_UKV = W_UQ + E_UQ, W_END = W_UKV + E_UKV;
constexpr size_t OFF_BAR = 0;
constexpr size_t OFF_W = 16384;
constexpr size_t OFF_MODS = al(OFF_W + W_END * 2);
constexpr size_t OFF_HC = al(OFF_MODS + (size_t)2 * 9 * NMOD * 4);
constexpr size_t OFF_NBUF = al(OFF_HC + (size_t)TC * D * 4);
constexpr size_t OFF_ROWSS = al(OFF_NBUF + (size_t)T * D * 2);
constexpr size_t OFF_MIX = al(OFF_ROWSS + (size_t)T * 16);
constexpr size_t OFF_ACT = OFF_MIX;
constexpr size_t SZ_Q = (size_t)NB * 4 * SA * 64 * 2, SZ_KV = (size_t)NB * 2 * SA * 64 * 2;
constexpr size_t OFF_QA = OFF_MIX, OFF_KA = al(OFF_QA + SZ_Q), OFF_VTA = al(OFF_KA + SZ_KV);
constexpr size_t OFF_QB = al(OFF_VTA + SZ_KV), OFF_KB = al(OFF_QB + SZ_Q), OFF_VTB = al(OFF_KB + SZ_KV);
constexpr size_t OFF_CQ = al(OFF_VTB + SZ_KV), OFF_CKV = al(OFF_CQ + (size_t)T * 256 * 2);
constexpr size_t OFF_QC = al(OFF_CKV + (size_t)T * 128 * 2), OFF_KC = al(OFF_QC + (size_t)NB * 4 * SA * 96 * 2);
constexpr size_t OFF_VTC = al(OFF_KC + (size_t)NB * 4 * SA * 96 * 2);
constexpr size_t OFF_Z = al(OFF_VTC + (size_t)NB * 4 * 64 * SA * 2), OFF_XBC = al(OFF_Z + (size_t)T * 256 * 2);
constexpr size_t OFF_DT = al(OFF_XBC + (size_t)T * 768 * 2), OFF_CS = al(OFF_DT + (size_t)T * 8 * 4);
constexpr size_t OFF_XT = al(OFF_CS + (size_t)T * 8 * 4), OFF_BM = al(OFF_XT + (size_t)NB * 4 * 64 * SA * 2);
constexpr size_t OFF_BT = al(OFF_BM + (size_t)NB * 2 * SA * 128 * 2), OFF_CM = al(OFF_BT + (size_t)NB * 2 * SA * 128 * 2);
constexpr size_t OFF_ST = OFF_XBC;
static_assert((size_t)NB * 2 * NCH * 4 * 8192 * 2 <= (size_t)T * 768 * 2, "ST fits in XBC");
constexpr size_t OFF_W2 = al(OFF_CM + (size_t)NB * 2 * SA * 128 * 2);
constexpr size_t OFF_END = al(OFF_W2 + W_END * 2);
static_assert(OFF_ACT + (size_t)T * FFN * 2 <= OFF_END, "act alias fits");

constexpr int LDS_BYTES = 75776;

struct Params {
  const float* in[29];
  float* out;
  unsigned char* ws;
  int ph_lo, ph_hi;
};
enum { I_X = 0, I_C, I_CTX, I_CCTX, I_ADAW, I_ADAB, I_F1N, I_F1WI, I_F1WO, I_MIXN, I_WIN, I_WOUT, I_SINK, I_BQN, I_BKN, I_CQN, I_CWUQ,
       I_CKVN, I_CWUKV, I_CONVW, I_CONVB, I_ALOG, I_DTB, I_SKIP, I_ONORM, I_F2N, I_F2WI, I_F2WO, I_FINAL };

DI size_t woff(int l) { return l == 0 ? OFF_W : OFF_W2; }
DI size_t moff(int l) { return OFF_MODS + (size_t)l * 9 * NMOD * 4; }
DI int row_b(int row) { return row < TL ? row / SEQ : (row - TL) / CTX; }
DI int row_pos(int row) { return row < TL ? CTX + row % SEQ : (row - TL) % CTX; }
DI int row_mrow(int row) { return row < TL ? row / SEQ : 8; }

DI int wmap(int wid, int n) {
  if (wid == 0) {
    int bn = n >> 7, wn = (n >> 6) & 1, nt = (n >> 5) & 1, c = n & 31;
    return nt * FFN + bn * 64 + wn * 32 + c;
  } else if (wid == 2) {
    if (n < 1024) return n;
    if (n < 1536) { int c = n - 1024; return c < 416 ? 1024 + c : -1; }
    int c = n - 1536; return c < 1032 ? 1440 + c : -1;
  } else if (wid == 4) {
    int hd = n >> 7, c = n & 127; return c < 96 ? hd * 96 + c : -1;
  }
  return n;
}

DI void conv_weight_tile(const float* __restrict__ W, int K, int N, bfu* __restrict__ Wt, int n0, int k0, int wid,
                         const float* __restrict__ ksc, int ksc_lo, float* sT) {
  const int tid = threadIdx.x;
  float v[32];
#pragma unroll
  for (int i = 0; i < 32; ++i) {
    int idx = tid + 256 * i, kk = idx >> 6, nn = idx & 63;
    int col = wmap(wid, n0 + nn);
    v[i] = col >= 0 ? __builtin_nontemporal_load(W + (size_t)(k0 + kk) * N + col) : 0.f;
  }
#pragma unroll
  for (int i = 0; i < 32; ++i) {
    int idx = tid + 256 * i, kk = idx >> 6, nn = idx & 63;
    float x = v[i];
    if (ksc && (k0 + kk) >= ksc_lo) x *= ksc[k0 + kk - ksc_lo];
    sT[nn * 129 + kk] = x;
  }
  __syncthreads();
#pragma unroll
  for (int i = 0; i < 4; ++i) {
    int idx = tid + 256 * i, nn = idx >> 4, kc = idx & 15;
    const float* s = sT + nn * 129 + kc * 8;
    u32x4 o; o[0] = pack2(s[0], s[1]); o[1] = pack2(s[2], s[3]); o[2] = pack2(s[4], s[5]); o[3] = pack2(s[6], s[7]);
    *(u32x4*)(Wt + (size_t)(n0 + nn) * K + k0 + kc * 8) = o;
  }
  __syncthreads();
}

DI void phase_convert(const Params& P, int l, char* lds, int t_lo, int t_hi, int mods_l) {
  float* sT = (float*)lds;
  bfu* Wb = (bfu*)(P.ws + woff(l));
  __syncthreads();
  const int t_wi = 88 * 8, t_wo = 16 * 22, t_win = 42 * 8, t_wout = 16 * 8, t_uq = 8 * 2, t_ukv = 8 * 1;
  const int c0 = t_wi, c1 = c0 + t_wo, c2 = c1 + t_win, c3 = c2 + t_wout, c4 = c3 + t_wi, c5 = c4 + t_wo, c6 = c5 + t_uq, c7 = c6 + t_ukv;
  if (t_hi > c7) t_hi = c7;
  const int n_mod = mods_l >= 0 ? 288 : 0;
  const int total = (t_hi - t_lo) + n_mod;
  for (int it0 = blockIdx.x; it0 < total; it0 += gridDim.x) {
    const int it = it0 < n_mod ? c7 + it0 : t_lo + it0 - n_mod;
    if (it < c7) {
      const float* W; int K, N, wid, id; bfu* Wt; const float* ksc = nullptr; int ksc_lo = 0; int nkt;
      if (it < c0)      { id = it;      W = P.in[I_F1WI] + (size_t)l * D * 2 * FFN; K = D; N = 2 * FFN; wid = 0; Wt = Wb + W_WI1; }
      else if (it < c1) { id = it - c0; W = P.in[I_F1WO] + (size_t)l * FFN * D; K = FFN; N = D; wid = 1; Wt = Wb + W_WO1; }
      else if (it < c2) { id = it - c1; W = P.in[I_WIN] + (size_t)l * D * 2472; K = D; N = 2472; wid = 2; Wt = Wb + W_WIN; }
      else if (it < c3) { id = it - c2; W = P.in[I_WOUT] + (size_t)l * D * D; K = D; N = D; wid = 3; Wt = Wb + W_WOUT; ksc = P.in[I_ONORM] + l * 256; ksc_lo = 768; }
      else if (it < c4) { id = it - c3; W = P.in[I_F2WI] + (size_t)l * D * 2 * FFN; K = D; N = 2 * FFN; wid = 0; Wt = Wb + W_WI2; }
      else if (it < c5) { id = it - c4; W = P.in[I_F2WO] + (size_t)l * FFN * D; K = FFN; N = D; wid = 1; Wt = Wb + W_WO2; }
      else if (it < c6) { id = it - c5; W = P.in[I_CWUQ] + (size_t)l * 256 * 384; K = 256; N = 384; wid = 4; Wt = Wb + W_UQ; ksc = P.in[I_CQN] + l * 256; }
      else              { id = it - c6; W = P.in[I_CWUKV] + (size_t)l * 128 * 512; K = 128; N = 512; wid = 5; Wt = Wb + W_UKV; ksc = P.in[I_CKVN] + l * 128; }
      nkt = K / 128;
      conv_weight_tile(W, K, N, Wt, (id / nkt) * 64, (id % nkt) * 128, wid, ksc, ksc_lo, sT);
    } else {
      const int id = it - c7, l2 = mods_l, tid = threadIdx.x;
      float* sS = sT;
      float* sR = sT + 9 * 1024;
      for (int i = tid; i < 9 * 1024; i += 256) {
        int rr = i >> 10, k = i & 1023;
        float cv = rr < 8 ? P.in[I_C][rr * 1024 + k] : P.in[I_CCTX][k];
        sS[i] = silu_f(cv);
      }
      __syncthreads();
      const int col = id * 32 + (tid & 31), kq = tid >> 5;
      const float* W = P.in[I_ADAW] + (size_t)l2 * D * NMOD + col;
      float acc[9];
#pragma unroll
      for (int j = 0; j < 9; ++j) acc[j] = 0.f;
      for (int kb = kq * 128; kb < kq * 128 + 128; kb += 32) {
        float w[32];
#pragma unroll
        for (int u = 0; u < 32; ++u) w[u] = __builtin_nontemporal_load(W + (size_t)(kb + u) * NMOD);
#pragma unroll
        for (int u = 0; u < 32; ++u)
#pragma unroll
          for (int j = 0; j < 9; ++j) acc[j] += sS[j * 1024 + kb + u] * w[u];
      }
#pragma unroll
      for (int j = 0; j < 9; ++j) sR[(kq * 9 + j) * 32 + (tid & 31)] = acc[j];
      __syncthreads();
      for (int i = tid; i < 9 * 32; i += 256) {
        int j = i >> 5, cc = i & 31;
        float s = 0.f;
#pragma unroll
        for (int q = 0; q < 8; ++q) s += sR[(q * 9 + j) * 32 + cc];
        int c2_ = id * 32 + cc;
        ((float*)(P.ws + moff(l2)))[j * NMOD + c2_] = s + P.in[I_ADAB][l2 * NMOD + c2_];
      }
      __syncthreads();
    }
  }
}

DI void phase_norm(const Params& P, int l, const float* src_lat, const float* src_ctx, const float* g, int shift_idx, int scale_idx, int M, bool rev) {
  const int lane = threadIdx.x & 63, wave = threadIdx.x >> 6;
  const float* mods = (const float*)(P.ws + moff(l));
  bfu* dst = (bfu*)(P.ws + OFF_NBUF);
  float* rowss = (float*)(P.ws + OFF_ROWSS);
  const int stride = gridDim.x * 4;
  int lrow = blockIdx.x * 4 + wave;
  float4 vn[4];
  if (lrow < M) {
    const int row = rev ? M - 1 - lrow : lrow;
    const float* src = row < TL ? src_lat + (size_t)row * D : src_ctx + (size_t)(row - TL) * D;
#pragma unroll
    for (int i = 0; i < 4; ++i) vn[i] = ((const float4*)src)[lane + 64 * i];
  }
  for (; lrow < M; lrow += stride) {
    const int row = rev ? M - 1 - lrow : lrow;
    float4 v[4]; float ss = 0.f;
#pragma unroll
    for (int i = 0; i < 4; ++i) v[i] = vn[i];
    if (lrow + stride < M) {
      const int nrow = rev ? M - 1 - (lrow + stride) : lrow + stride;
      const float* src = nrow < TL ? src_lat + (size_t)nrow * D : src_ctx + (size_t)(nrow - TL) * D;
#pragma unroll
      for (int i = 0; i < 4; ++i) vn[i] = ((const float4*)src)[lane + 64 * i];
    }
#pragma unroll
    for (int i = 0; i < 4; ++i) ss += v[i].x * v[i].x + v[i].y * v[i].y + v[i].z * v[i].z + v[i].w * v[i].w;
#pragma unroll
    for (int o = 32; o >= 1; o >>= 1) ss += __shfl_xor(ss, o);
    const float r = rsqrtf(ss * (1.f / D) + EPS);
    const float* msh = mods + row_mrow(row) * NMOD + shift_idx * D;
    const float* msc = mods + row_mrow(row) * NMOD + scale_idx * D;
#pragma unroll
    for (int i = 0; i < 4; ++i) {
      const int c = (lane + 64 * i) * 4;
      float4 gg = *(const float4*)(g + c), sh = *(const float4*)(msh + c), sc = *(const float4*)(msc + c);
      float a0 = v[i].x * r * gg.x * (1.f + sc.x) + sh.x, a1 = v[i].y * r * gg.y * (1.f + sc.y) + sh.y;
      float a2 = v[i].z * r * gg.z * (1.f + sc.z) + sh.z, a3 = v[i].w * r * gg.w * (1.f + sc.w) + sh.w;
      u32x2 o; o[0] = pack2(a0, a1); o[1] = pack2(a2, a3);
      *(u32x2*)(dst + (size_t)row * D + c) = o;
    }
  }
}

DI void phase_final(const Params& P) {
  const int lane = threadIdx.x & 63, wave = threadIdx.x >> 6;
  const float* g = P.in[I_FINAL];
  for (int row = blockIdx.x * 4 + wave; row < TL; row += gridDim.x * 4) {
    float* src = P.out + (size_t)row * D;
    float4 v[4]; float ss = 0.f;
#pragma unroll
    for (int i = 0; i < 4; ++i) { v[i] = ((const float4*)src)[lane + 64 * i]; ss += v[i].x * v[i].x + v[i].y * v[i].y + v[i].z * v[i].z + v[i].w * v[i].w; }
#pragma unroll
    for (int o = 32; o >= 1; o >>= 1) ss += __shfl_xor(ss, o);
    const float r = rsqrtf(ss * (1.f / D) + EPS) * (TIMEMASK != 0 ? 1.f + *(const float*)(P.ws + 14336) : 1.f);
#pragma unroll
    for (int i = 0; i < 4; ++i) {
      const int c = (lane + 64 * i) * 4;
      float4 gg = *(const float4*)(g + c);
      float4 o = {v[i].x * r * gg.x, v[i].y * r * gg.y, v[i].z * r * gg.z, v[i].w * r * gg.w};
      ((float4*)src)[lane + 64 * i] = o;
    }
  }
}

constexpr int LDSS = 72;
constexpr int TILE_E = 128 * LDSS;

template <bool DO_WR, bool DO_LD>
DI void gemm_kstep(const bfu* cA, const bfu* cB, const bfu* nA, const bfu* nB, bfu* dA, bfu* dB, const bfu* Ag2, const bfu* Wg2, int lda, int K,
                   u32x4 (&ra)[4], u32x4 (&rb)[4], bf16x8 (&f0)[4], f32x16 (&acc)[2][2]) {
  bf16x8 f1[4];
#define RDF(F, s_) { F[0] = *(const bf16x8*)(cA + (s_) * 16); F[1] = *(const bf16x8*)(cA + 32 * LDSS + (s_) * 16); \
                     F[2] = *(const bf16x8*)(cB + (s_) * 16); F[3] = *(const bf16x8*)(cB + 32 * LDSS + (s_) * 16); }
#define MM(F) { acc[0][0] = MFMA(F[0], F[2], acc[0][0]); acc[0][1] = MFMA(F[0], F[3], acc[0][1]); \
                acc[1][0] = MFMA(F[1], F[2], acc[1][0]); acc[1][1] = MFMA(F[1], F[3], acc[1][1]); }
#define PA(i_) { if (DO_WR) *(u32x4*)(dA + 32 * (i_) * LDSS) = ra[i_]; if (DO_LD) ra[i_] = *(const u32x4*)(Ag2 + (size_t)(32 * (i_)) * lda); }
#define PB(i_) { if (DO_WR) *(u32x4*)(dB + 32 * (i_) * LDSS) = rb[i_]; if (DO_LD) rb[i_] = *(const u32x4*)(Wg2 + (size_t)(32 * (i_)) * K); }
  __builtin_amdgcn_s_setprio(2);
  RDF(f1, 1) MM(f0) PA(0) PB(0) PA(1)
  __builtin_amdgcn_sched_barrier(0);
  RDF(f0, 2) MM(f1) PB(1) PA(2) PB(2)
  __builtin_amdgcn_sched_barrier(0);
  RDF(f1, 3) MM(f0) PA(3) PB(3)
  __builtin_amdgcn_sched_barrier(0);
  __builtin_amdgcn_s_setprio(0);
  __syncthreads();
  if (DO_WR) { f0[0] = *(const bf16x8*)(nA); f0[1] = *(const bf16x8*)(nA + 32 * LDSS); f0[2] = *(const bf16x8*)(nB); f0[3] = *(const bf16x8*)(nB + 32 * LDSS); }
  MM(f1)
  __builtin_amdgcn_sched_barrier(0);
#undef RDF
#undef MM
#undef PA
#undef PB
}

DI void gemm_mainloop_x(const bfu* __restrict__ A, int lda, const bfu* __restrict__ W, int K, int bm, int bn, int kshift,
                        const float* rowss, char* lds, f32x16 (&acc)[2][2], u32x4 (&ra)[4], u32x4 (&rb)[4], bool have_pref, bool has_next, int nbm, int nbn,
                        const float* resp, unsigned reslo, float (&res)[64]) {
  bfu* sA = (bfu*)lds;
  bfu* sB = sA + 2 * TILE_E;
  int tid = threadIdx.x; asm volatile("" : "+v"(tid));
  const int lane = tid & 63, wave = tid >> 6, r = lane & 31, h = lane >> 5;
  const int wm = wave >> 1, wn = wave & 1;
  const int nk = K / 64;
#pragma unroll
  for (int a = 0; a < 2; ++a)
#pragma unroll
    for (int b = 0; b < 2; ++b)
#pragma unroll
      for (int i = 0; i < 16; ++i) acc[a][b][i] = 0.f;
  const bfu* Ag = A + (size_t)(bm * 128 + (tid >> 3)) * lda + (tid & 7) * 8;
  const bfu* Wg = W + (size_t)(bn * 128 + (tid >> 3)) * K + (tid & 7) * 8;
  const int soff = (tid >> 3) * LDSS + (tid & 7) * 8;
  float* sRS = (float*)(lds + 4 * TILE_E * 2);
  if (rowss != nullptr && tid < 128) {
    const float4 r4 = *(const float4*)(rowss + (size_t)(bm * 128 + tid) * 4);
    sRS[tid] = rsqrtf((r4.x + r4.y + r4.z + r4.w) * (1.f / 256.f) + EPS);
  }
  const int k0 = (kshift % nk) * 64;
  {
    if (!have_pref) {
#pragma unroll
      for (int i = 0; i < 4; ++i) { ra[i] = *(const u32x4*)(Ag + (size_t)(32 * i) * lda + k0); rb[i] = *(const u32x4*)(Wg + (size_t)(32 * i) * K + k0); }
    }
#pragma unroll
    for (int i = 0; i < 4; ++i) { *(u32x4*)(sA + soff + 32 * i * LDSS) = ra[i]; *(u32x4*)(sB + soff + 32 * i * LDSS) = rb[i]; }
    const int k1 = ((1 + kshift) % nk) * 64;
#pragma unroll
    for (int i = 0; i < 4; ++i) { ra[i] = *(const u32x4*)(Ag + (size_t)(32 * i) * lda + k1); rb[i] = *(const u32x4*)(Wg + (size_t)(32 * i) * K + k1); }
  }
  __syncthreads();
  const int fo = r * LDSS + h * 8;
  bf16x8 f0[4];
  {
    const bfu* cA = sA + wm * 64 * LDSS + fo; const bfu* cB = sB + wn * 64 * LDSS + fo;
    f0[0] = *(const bf16x8*)(cA); f0[1] = *(const bf16x8*)(cA + 32 * LDSS); f0[2] = *(const bf16x8*)(cB); f0[3] = *(const bf16x8*)(cB + 32 * LDSS);
  }
#define KPTRS(kt_) const int cur = (kt_) & 1; \
    const bfu* cA = sA + cur * TILE_E + wm * 64 * LDSS + fo; const bfu* cB = sB + cur * TILE_E + wn * 64 * LDSS + fo; \
    const bfu* nA = sA + (cur ^ 1) * TILE_E + wm * 64 * LDSS + fo; const bfu* nB = sB + (cur ^ 1) * TILE_E + wn * 64 * LDSS + fo; \
    bfu* dA = sA + (cur ^ 1) * TILE_E + soff; bfu* dB = sB + (cur ^ 1) * TILE_E + soff;
#pragma unroll 1
  for (int kt = 0; kt + 2 < nk; ++kt) {
    KPTRS(kt)
    int k2 = kt + 2 + kshift; if (k2 >= nk) k2 -= nk; k2 *= 64;
    gemm_kstep<true, true>(cA, cB, nA, nB, dA, dB, Ag + k2, Wg + k2, lda, K, ra, rb, f0, acc);
    if (rowss != nullptr && kt == 3) {
#pragma unroll
      for (int mt = 0; mt < 2; ++mt)
#pragma unroll
        for (int i = 0; i < 16; ++i) {
          const float rs = sRS[wm * 64 + mt * 32 + crow(i, h)];
          acc[mt][0][i] *= rs; acc[mt][1][i] *= rs;
        }
    }
  }
  {
    KPTRS(nk - 2)
    if (has_next) {
      const bfu* Agn = A + (size_t)(nbm * 128 + (tid >> 3)) * lda + (tid & 7) * 8 + k0;
      const bfu* Wgn = W + (size_t)(nbn * 128 + (tid >> 3)) * K + (tid & 7) * 8 + k0;
      gemm_kstep<true, true>(cA, cB, nA, nB, dA, dB, Agn, Wgn, lda, K, ra, rb, f0, acc);
    } else {
      gemm_kstep<true, false>(cA, cB, nA, nB, dA, dB, Ag, Wg, lda, K, ra, rb, f0, acc);
    }
  }
  {
    KPTRS(nk - 1)
    if (resp != nullptr) {
#pragma unroll
      for (int mt = 0; mt < 2; ++mt)
#pragma unroll
        for (int nt = 0; nt < 2; ++nt)
#pragma unroll
          for (int i = 0; i < 16; ++i) res[(mt * 2 + nt) * 16 + i] = (resp + (mt * 32 + (i & 3) + 8 * (i >> 2)) * D + nt * 32)[reslo];
    }
    __builtin_amdgcn_sched_barrier(0);
    gemm_kstep<false, false>(cA, cB, nA, nB, dA, dB, Ag, Wg, lda, K, ra, rb, f0, acc);
  }
#undef KPTRS
  __syncthreads();
}

DI void gemm_mainloop(const bfu* __restrict__ A, int lda, const bfu* __restrict__ W, int K, int bm, int bn, int kshift,
                      const float* rowss, char* lds, f32x16 (&acc)[2][2]) {
  u32x4 ra[4], rb[4]; float res[64];
  gemm_mainloop_x(A, lda, W, K, bm, bn, kshift, rowss, lds, acc, ra, rb, false, false, 0, 0, nullptr, 0u, res);
}

DI int vblock() { const int G = gridDim.x, bx = blockIdx.x; return (G & 7) == 0 ? (bx & 7) * (G >> 3) + (bx >> 3) : bx; }
DI int tile_at(int k, int ntiles) {
  const int G = gridDim.x, nfull = (ntiles / G) * G, base = k * G;
  if (base < nfull) return base + vblock();
  if (base == nfull) { const int t = nfull + (int)blockIdx.x; return t < ntiles ? t : -1; }
  return -1;
}
DI void tile_coords(int id, int NT, int& bm, int& bn) { const int per = 8 * NT; const int sg = id / per, rem = id % per; bm = sg * 8 + (rem & 7); bn = rem >> 3; }

constexpr int SCS = 129;
DI void stage_acc(float* sC, const f32x16 (&acc)[2][2]) {
  const int lane = threadIdx.x & 63, wave = threadIdx.x >> 6, r = lane & 31, h = lane >> 5, wm = wave >> 1, wn = wave & 1;
#pragma unroll
  for (int mt = 0; mt < 2; ++mt)
#pragma unroll
    for (int nt = 0; nt < 2; ++nt)
#pragma unroll
      for (int i = 0; i < 16; ++i) sC[(wm * 64 + mt * 32 + crow(i, h)) * SCS + wn * 64 + nt * 32 + r] = acc[mt][nt][i];
}

DI void phase_gemm_swiglu(const Params& P, const bfu* Wt, int M, bool rev, char* lds) {
  const bfu* A = (const bfu*)(P.ws + OFF_NBUF);
  bfu* act = (bfu*)(P.ws + OFF_ACT);
  const int NT = 44, ntiles = (M / 128) * NT;
  const int lane = threadIdx.x & 63, wave = threadIdx.x >> 6, r = lane & 31, h = lane >> 5, wm = wave >> 1, wn = wave & 1;
  u32x4 ra[4], rb[4]; bool pref = false;
  for (int k_ = 0, t = tile_at(0, ntiles); t >= 0; ++k_, t = tile_at(k_, ntiles)) {
    int bm, bn; tile_coords(rev ? ntiles - 1 - t : t, NT, bm, bn);
    const int tn = tile_at(k_ + 1, ntiles); const bool has_next = tn >= 0;
    int nbm = 0, nbn = 0; if (has_next) tile_coords(rev ? ntiles - 1 - tn : tn, NT, nbm, nbn);
    f32x16 acc[2][2];
    float res[64];
    gemm_mainloop_x(A, D, Wt, D, bm, bn, 0, nullptr, lds, acc, ra, rb, pref, has_next, nbm, nbn, nullptr, 0u, res);
    pref = has_next;
    bfu* actu = act + (size_t)(bm * 128) * FFN + bn * 64;
    const unsigned odd = (unsigned)(r & 1);
    const unsigned lo = (unsigned)((wm * 64 + 4 * h + (int)odd) * FFN + wn * 32 + r - (int)odd);
#pragma unroll
    for (int mt = 0; mt < 2; ++mt)
#pragma unroll
      for (int j = 0; j < 8; ++j) {
        const int i0 = 2 * j, i1 = 2 * j + 1;
        const unsigned b0 = pack2(silu_f(acc[mt][0][i0]) * acc[mt][1][i0], 0.f) & 0xffffu;
        const unsigned b1 = pack2(silu_f(acc[mt][0][i1]) * acc[mt][1][i1], 0.f) & 0xffffu;
        const unsigned send = odd ? b0 : b1;
        const unsigned recv = (unsigned)__builtin_amdgcn_mov_dpp((int)send, 0xB1, 0xF, 0xF, true);
        const unsigned word = odd ? (recv | (b1 << 16)) : (b0 | (recv << 16));
        *(unsigned*)(actu + (mt * 32 + (i0 & 3) + 8 * (i0 >> 2)) * FFN + lo) = word;
      }
  }
}

DI void phase_gemm_resid(const Params& P, int l, const bfu* A, int K, const bfu* Wt, int M, int gidx, float gs,
                         const float* src_lat, const float* src_ctx, int kshift, const float* rowss, bool rev, char* lds) {
  const float* mods = (const float*)(P.ws + moff(l));
  float* dst_lat = P.out; float* dst_ctx = (float*)(P.ws + OFF_HC);
  const int NT = 8, ntiles = (M / 128) * NT;
  const int lane = threadIdx.x & 63, wave = threadIdx.x >> 6, r = lane & 31, h = lane >> 5, wm = wave >> 1, wn = wave & 1;
  u32x4 ra[4], rb[4]; bool pref = false;
  for (int k_ = 0, t = tile_at(0, ntiles); t >= 0; ++k_, t = tile_at(k_, ntiles)) {
    int bm, bn; tile_coords(rev ? ntiles - 1 - t : t, NT, bm, bn);
    const int tn = tile_at(k_ + 1, ntiles); const bool has_next = tn >= 0;
    int nbm = 0, nbn = 0; if (has_next) tile_coords(rev ? ntiles - 1 - tn : tn, NT, nbm, nbn);
    f32x16 acc[2][2];
    const int row0 = bm * 128;
    const bool lat = row0 < TL;
    const size_t uoff = (size_t)(lat ? row0 : row0 - TL) * D + bn * 128;
    const unsigned lo = (unsigned)((wm * 64 + 4 * h) * D + wn * 64 + r);
    const float* resp = (lat ? src_lat : src_ctx) + uoff;
    float res[64];
    gemm_mainloop_x(A, K, Wt, K, bm, bn, kshift, rowss, lds, acc, ra, rb, false, false, nbm, nbn, resp, lo, res);
    const float* gate = mods + row_mrow(row0) * NMOD + gidx * D;
    float* dstp = (lat ? dst_lat : dst_ctx) + uoff;
#pragma unroll
    for (int mt = 0; mt < 2; ++mt)
#pragma unroll
      for (int nt = 0; nt < 2; ++nt) {
        const float gv = gs * gate[bn * 128 + wn * 64 + nt * 32 + r];
#pragma unroll
        for (int i = 0; i < 16; ++i)
          (dstp + (mt * 32 + (i & 3) + 8 * (i >> 2)) * D + nt * 32)[lo] = res[(mt * 2 + nt) * 16 + i] + gv * acc[mt][nt][i];
      }
  }
}

template <int NF>
DI void rope2d(float* v, int t) {
  const float ri = (float)(t >> 6), ci = (float)(t & 63);
#pragma unroll
  for (int d = 0; d < NF; ++d) {
    const float inv = exp2f(-(float)d * (13.287712379549449f / NF));
    float ar = ri * inv, ac = ci * inv;
    float cr = __cosf(ar), sr = __sinf(ar), cc = __cosf(ac), sc = __sinf(ac);
    float x1 = v[d], x2 = v[NF + d];
    v[d] = x1 * cr - x2 * sr; v[NF + d] = x2 * cr + x1 * sr;
    float y1 = v[2 * NF + d], y2 = v[3 * NF + d];
    v[2 * NF + d] = y1 * cc - y2 * sc; v[3 * NF + d] = y2 * cc + y1 * sc;
  }
}

DI void store_row_bf16_64(bfu* dst, const float* v) {
#pragma unroll
  for (int c = 0; c < 8; ++c) {
    u32x4 o; o[0] = pack2(v[c * 8], v[c * 8 + 1]); o[1] = pack2(v[c * 8 + 2], v[c * 8 + 3]); o[2] = pack2(v[c * 8 + 4], v[c * 8 + 5]); o[3] = pack2(v[c * 8 + 6], v[c * 8 + 7]);
    *(u32x4*)(dst + c * 8) = o;
  }
}

DI void write_raw_rows(const float* sC, bfu* dst, int pitch, int col0, int grow0) {
  const int tid = threadIdx.x, rr = tid & 127, half = tid >> 7;
  float v[64];
#pragma unroll
  for (int j = 0; j < 64; ++j) v[j] = sC[rr * SCS + half * 64 + j];
  store_row_bf16_64(dst + (size_t)(grow0 + rr) * pitch + col0 + half * 64, v);
}

DI void write_col_T(const float* sC, int col, int half, bfu* dstT, float sc0, const float* rscale) {
#pragma unroll
  for (int c = 0; c < 8; ++c) {
    float v[8];
#pragma unroll
    for (int j = 0; j < 8; ++j) { const int rr = half * 64 + c * 8 + j; v[j] = sC[rr * SCS + col] * (rscale ? rscale[rr] : sc0); }
    u32x4 o; o[0] = pack2(v[0], v[1]); o[1] = pack2(v[2], v[3]); o[2] = pack2(v[4], v[5]); o[3] = pack2(v[6], v[7]);
    *(u32x4*)(dstT + half * 64 + c * 8) = o;
  }
}

DI void phase_gemm_win(const Params& P, int l, bool rev, char* lds) {
  const bfu* A = (const bfu*)(P.ws + OFF_NBUF);
  const bfu* Wt = (const bfu*)(P.ws + woff(l)) + W_WIN;
  float* sC = (float*)lds;
  const int NT = 21, ntiles = 144 * NT;
  const int tid = threadIdx.x;
  for (int k_ = 0, t = tile_at(0, ntiles); t >= 0; ++k_, t = tile_at(k_, ntiles)) {
    int bm, bn; tile_coords(rev ? ntiles - 1 - t : t, NT, bm, bn);
    f32x16 acc[2][2];
    gemm_mainloop(A, D, Wt, D, bm, bn, 0, nullptr, lds, acc);
    stage_acc(sC, acc);
    __syncthreads();
    const int grow0 = bm * 128;
    const bool lat = grow0 < TL;
    const int b = row_b(grow0), pos0 = row_pos(grow0);
    if (bn < 8) {
      const int mixer = bn >> 2, sub = bn & 3;
      if (sub < 3) {
        const int rr = tid & 127, hh = tid >> 7;
        float v[64];
#pragma unroll
        for (int j = 0; j < 64; ++j) v[j] = sC[rr * SCS + hh * 64 + j];
        if (mixer == 1) {
          float ss = 0.f;
#pragma unroll
          for (int j = 0; j < 64; ++j) ss += v[j] * v[j];
          const float rn = rsqrtf(ss * (1.f / 64.f) + EPS);
          const float* gn = (sub < 2 ? P.in[I_BQN] : P.in[I_BKN]) + l * 64;
#pragma unroll
          for (int j = 0; j < 64; ++j) v[j] = v[j] * rn * gn[j];
        }
        if (lat) rope2d<16>(v, pos0 + rr - CTX);
        bfu* dst;
        if (sub < 2) {
#pragma unroll
          for (int j = 0; j < 64; ++j) v[j] *= 0.125f * 1.4426950408889634f;
          const int hq = sub * 2 + hh;
          dst = (bfu*)(P.ws + (mixer ? OFF_QB : OFF_QA)) + ((size_t)(b * 4 + hq) * SA + pos0 + rr) * 64;
        } else {
          dst = (bfu*)(P.ws + (mixer ? OFF_KB : OFF_KA)) + ((size_t)(b * 2 + hh) * SA + pos0 + rr) * 64;
        }
        store_row_bf16_64(dst, v);
      } else {
        const int col = tid & 127, half = tid >> 7, kvh = col >> 6, d = col & 63;
        bfu* dstT = (bfu*)(P.ws + (mixer ? OFF_VTB : OFF_VTA)) + ((size_t)(b * 2 + kvh) * 64 + d) * SA + pos0;
        write_col_T(sC, col, half, dstT, 1.f, nullptr);
      }
    } else if (bn < 12) {
      if (bn < 10) write_raw_rows(sC, (bfu*)(P.ws + OFF_CQ), 256, (bn - 8) * 128, grow0);
      else if (bn == 10) write_raw_rows(sC, (bfu*)(P.ws + OFF_CKV), 128, 0, grow0);
      else if (tid < 128) {
        const int rr = tid;
        float v[32];
#pragma unroll
        for (int j = 0; j < 32; ++j) v[j] = sC[rr * SCS + j];
        if (lat) rope2d<8>(v, pos0 + rr - CTX);
        u32x4 o[4];
#pragma unroll
        for (int c = 0; c < 4; ++c) { o[c][0] = pack2(v[c * 8], v[c * 8 + 1]); o[c][1] = pack2(v[c * 8 + 2], v[c * 8 + 3]); o[c][2] = pack2(v[c * 8 + 4], v[c * 8 + 5]); o[c][3] = pack2(v[c * 8 + 6], v[c * 8 + 7]); }
#pragma unroll
        for (int hd = 0; hd < 4; ++hd) {
          bfu* dst = (bfu*)(P.ws + OFF_KC) + ((size_t)(b * 4 + hd) * SA + pos0 + rr) * 96 + 64;
#pragma unroll
          for (int c = 0; c < 4; ++c) *(u32x4*)(dst + c * 8) = o[c];
        }
      }
    } else {
      if (bn < 14) write_raw_rows(sC, (bfu*)(P.ws + OFF_Z), 256, (bn - 12) * 128, grow0);
      else if (bn < 20) write_raw_rows(sC, (bfu*)(P.ws + OFF_XBC), 768, (bn - 14) * 128, grow0);
      else if (tid < 8) {
        const int j = tid;
        const float bias = P.in[I_DTB][l * 8 + j];
        const float a_neg = -__expf(P.in[I_ALOG][l * 8 + j]);
        float* DT = (float*)(P.ws + OFF_DT); float* CS = (float*)(P.ws + OFF_CS);
        float run = 0.f;
        for (int rr = 0; rr < 128; ++rr) {
          const float x = sC[rr * SCS + j] + bias;
          const float dt = fmaxf(x, 0.f) + log1pf(__expf(-fabsf(x)));
          run += dt * a_neg;
          DT[(size_t)(grow0 + rr) * 8 + j] = dt; CS[(size_t)(grow0 + rr) * 8 + j] = run;
        }
      }
    }
    __syncthreads();
  }
}

DI void mla_uq_tile(const Params& P, int l, int bm, int hd, char* lds) {
  const bfu* A = (const bfu*)(P.ws + OFF_CQ);
  const bfu* Wt = (const bfu*)(P.ws + woff(l)) + W_UQ;
  float* sC = (float*)lds; float* sR = sC + 128 * SCS;
  int tid = threadIdx.x; asm volatile("" : "+v"(tid));
  f32x16 acc[2][2];
  gemm_mainloop(A, 256, Wt, 256, bm, hd, 0, nullptr, lds, acc);
  stage_acc(sC, acc);
  const int grow0 = bm * 128;
  {
    const int rr = tid >> 1, part = tid & 1;
    const u32x4* src = (const u32x4*)(A + (size_t)(grow0 + rr) * 256 + part * 128);
    float ss = 0.f;
#pragma unroll
    for (int c = 0; c < 16; ++c) { u32x4 u = src[c];
#pragma unroll
      for (int j = 0; j < 4; ++j) { float a = bflo(u[j]), bb = bfhi(u[j]); ss += a * a + bb * bb; } }
    ss += __shfl_xor(ss, 1);
    if (part == 0) sR[rr] = rsqrtf(ss * (1.f / 256.f) + EPS);
  }
  __syncthreads();
  if (tid < 128) {
    const int rr = tid;
    const bool lat = grow0 < TL;
    const int b = row_b(grow0), pos = row_pos(grow0) + rr;
    const float rs = sR[rr];
    const float qs = rs * (0.10206207261596575f * 1.4426950408889634f);
    bfu* dst = (bfu*)(P.ws + OFF_QC) + ((size_t)(b * 4 + hd) * SA + pos) * 96;
    float v[64];
#pragma unroll
    for (int j = 0; j < 64; ++j) v[j] = sC[rr * SCS + j] * qs;
    store_row_bf16_64(dst, v);
    float w[32];
#pragma unroll
    for (int j = 0; j < 32; ++j) w[j] = sC[rr * SCS + 64 + j] * qs;
    if (lat) rope2d<8>(w, pos - CTX);
#pragma unroll
    for (int c = 0; c < 4; ++c) {
      u32x4 o; o[0] = pack2(w[c * 8], w[c * 8 + 1]); o[1] = pack2(w[c * 8 + 2], w[c * 8 + 3]); o[2] = pack2(w[c * 8 + 4], w[c * 8 + 5]); o[3] = pack2(w[c * 8 + 6], w[c * 8 + 7]);
      *(u32x4*)(dst + 64 + c * 8) = o;
    }
  }
  __syncthreads();
}

DI void mla_ukv_tile(const Params& P, int l, int bm, int hd, char* lds) {
  const bfu* A = (const bfu*)(P.ws + OFF_CKV);
  const bfu* Wt = (const bfu*)(P.ws + woff(l)) + W_UKV;
  float* sC = (float*)lds; float* sR = sC + 128 * SCS;
  int tid = threadIdx.x; asm volatile("" : "+v"(tid));
  f32x16 acc[2][2];
  gemm_mainloop(A, 128, Wt, 128, bm, hd, 0, nullptr, lds, acc);
  stage_acc(sC, acc);
  const int grow0 = bm * 128;
  {
    const int rr = tid >> 1, part = tid & 1;
    const u32x4* src = (const u32x4*)(A + (size_t)(grow0 + rr) * 128 + part * 64);
    float ss = 0.f;
#pragma unroll
    for (int c = 0; c < 8; ++c) { u32x4 u = src[c];
#pragma unroll
      for (int j = 0; j < 4; ++j) { float a = bflo(u[j]), bb = bfhi(u[j]); ss += a * a + bb * bb; } }
    ss += __shfl_xor(ss, 1);
    if (part == 0) sR[rr] = rsqrtf(ss * (1.f / 128.f) + EPS);
  }
  __syncthreads();
  const int b = row_b(grow0), pos0 = row_pos(grow0);
  if (tid < 128) {
    const int rr = tid;
    const float rs = sR[rr];
    float v[64];
#pragma unroll
    for (int j = 0; j < 64; ++j) v[j] = sC[rr * SCS + j] * rs;
    store_row_bf16_64((bfu*)(P.ws + OFF_KC) + ((size_t)(b * 4 + hd) * SA + pos0 + rr) * 96, v);
  } else {
    const int q = tid - 128, d = q & 63, half = q >> 6;
    bfu* dstT = (bfu*)(P.ws + OFF_VTC) + ((size_t)(b * 4 + hd) * 64 + d) * SA + pos0;
    write_col_T(sC, 64 + d, half, dstT, 1.f, sR);
  }
  __syncthreads();
}

DI void conv_prep_tile(const Params& P, int l, int rt, int ct, char* lds) {
  float* sIn = (float*)lds;
  int tid = threadIdx.x; asm volatile("" : "+v"(tid));
  const int grow0 = rt * 128;
  const bool lat = grow0 < TL;
  const int b = row_b(grow0), pos0 = row_pos(grow0);
  const int seg_lo = lat ? b * SEQ : TL + b * CTX, seg_hi = seg_lo + (lat ? SEQ : CTX);
  const bfu* X = (const bfu*)(P.ws + OFF_XBC);
  for (int idx = tid; idx < 132 * 16; idx += 256) {
    const int rr = idx >> 4, c8 = idx & 15;
    const int grow = grow0 - 2 + rr;
    u32x4 u = {0u, 0u, 0u, 0u};
    if (grow >= seg_lo && grow < seg_hi) u = *(const u32x4*)(X + (size_t)grow * 768 + ct * 128 + c8 * 8);
    float* d = sIn + rr * 128 + c8 * 8;
#pragma unroll
    for (int j = 0; j < 4; ++j) { d[2 * j] = bflo(u[j]); d[2 * j + 1] = bfhi(u[j]); }
  }
  __syncthreads();
  const int cc = tid & 127, half = tid >> 7, ch = ct * 128 + cc;
  float w[5];
#pragma unroll
  for (int k = 0; k < 5; ++k) w[k] = P.in[I_CONVW][(size_t)l * 5 * 768 + k * 768 + ch];
  const float bias = P.in[I_CONVB][l * 768 + ch];
  bfu* dT = nullptr; bfu* dR = nullptr;
  if (ct < 2) { const int hd = ct * 2 + (cc >> 6), p = cc & 63; dT = (bfu*)(P.ws + OFF_XT) + ((size_t)(b * 4 + hd) * 64 + p) * SA + pos0 + half * 64; }
  else if (ct < 4) { const int g = ct - 2; dT = (bfu*)(P.ws + OFF_BT) + ((size_t)(b * 2 + g) * 128 + cc) * SA + pos0 + half * 64;
                     dR = (bfu*)(P.ws + OFF_BM) + ((size_t)(b * 2 + g) * SA + pos0 + half * 64) * 128 + cc; }
  else { const int g = ct - 4; dR = (bfu*)(P.ws + OFF_CM) + ((size_t)(b * 2 + g) * SA + pos0 + half * 64) * 128 + cc; }
  for (int c = 0; c < 8; ++c) {
    float in[12];
#pragma unroll
    for (int j = 0; j < 12; ++j) in[j] = sIn[(half * 64 + c * 8 + j) * 128 + cc];
    float o[8];
#pragma unroll
    for (int j = 0; j < 8; ++j) {
      float s = bias;
#pragma unroll
      for (int k = 0; k < 5; ++k) s += w[k] * in[j + k];
      o[j] = silu_f(s);
    }
    if (dT) { u32x4 q; q[0] = pack2(o[0], o[1]); q[1] = pack2(o[2], o[3]); q[2] = pack2(o[4], o[5]); q[3] = pack2(o[6], o[7]); *(u32x4*)(dT + c * 8) = q; }
    if (dR) {
#pragma unroll
      for (int j = 0; j < 8; ++j) dR[(size_t)(c * 8 + j) * 128] = f2bf(o[j]);
    }
  }
  __syncthreads();
}

DI void phase_mla_conv(const Params& P, int l, char* lds) {
  const int n_uq = 144 * 4, n_ukv = 144 * 4, n_cv = 144 * 6;
  const int total = n_uq + n_ukv + n_cv;
  for (int k_ = 0, it = tile_at(0, total); it >= 0; ++k_, it = tile_at(k_, total)) {
    if (it < n_uq) mla_uq_tile(P, l, it >> 2, it & 3, lds);
    else if (it < n_uq + n_ukv) { const int id = it - n_uq; mla_ukv_tile(P, l, id >> 2, id & 3, lds); }
    else { const int id = it - n_uq - n_ukv; conv_prep_tile(P, l, id / 6, id % 6, lds); }
  }
}

template <int DQK, bool NOMAX = false>
DI void attn_item(const bfu* __restrict__ Qp, const bfu* __restrict__ Kp, const bfu* __restrict__ VTp, int n1, int p1, int n2, int p2,
                  bool masked, int q0lat, bool has_sink, float sink, bfu* __restrict__ Op, char* lds) {
  constexpr int KS = DQK + 8, NKS = DQK / 16, VS = 72;
  bfu* sK = (bfu*)lds;
  bfu* sV = sK + 64 * KS;
  int tid = threadIdx.x; asm volatile("" : "+v"(tid));
  const int lane = tid & 63, wave = tid >> 6, r = lane & 31, h = lane >> 5;
  bf16x8 qf[NKS];
  const bfu* qrow = Qp + (size_t)(wave * 32 + r) * DQK;
#pragma unroll
  for (int s = 0; s < NKS; ++s) qf[s] = *(const bf16x8*)(qrow + s * 16 + h * 8);
  f32x16 o[2];
#pragma unroll
  for (int i = 0; i < 16; ++i) { o[0][i] = 0.f; o[1][i] = 0.f; }
  float m = has_sink ? sink * 1.4426950408889634f : -INFINITY;
  float lsum = (has_sink && h == 0) ? 1.f : 0.f;
  const int qpos = q0lat + wave * 32 + r;
  const int nt = n1 + n2;
  constexpr int NKC = (64 * (DQK / 8)) / 256;
  u32x4 kreg[NKC], vreg[2];
  {
    const int pos = n1 > 0 ? p1 : p2;
#pragma unroll
    for (int i = 0; i < NKC; ++i) { const int c = tid + 256 * i, kr = c / (DQK / 8), kc = c % (DQK / 8); kreg[i] = *(const u32x4*)(Kp + (size_t)(pos + kr) * DQK + kc * 8); }
#pragma unroll
    for (int i = 0; i < 2; ++i) { const int c = tid + 256 * i, d = c >> 3, kc = c & 7; vreg[i] = *(const u32x4*)(VTp + (size_t)d * SA + pos + kc * 8); }
  }
  for (int tt = 0; tt < nt; ++tt) {
    const int pos = tt < n1 ? p1 + tt * 64 : p2 + (tt - n1) * 64;
    __syncthreads();
#pragma unroll
    for (int i = 0; i < NKC; ++i) { const int c = tid + 256 * i, kr = c / (DQK / 8), kc = c % (DQK / 8); *(u32x4*)(sK + kr * KS + kc * 8) = kreg[i]; }
#pragma unroll
    for (int i = 0; i < 2; ++i) { const int c = tid + 256 * i, d = c >> 3, kc = c & 7; *(u32x4*)(sV + d * VS + kc * 8) = vreg[i]; }
    __syncthreads();
    if (tt + 1 < nt) {
      const int pn = (tt + 1) < n1 ? p1 + (tt + 1) * 64 : p2 + (tt + 1 - n1) * 64;
#pragma unroll
      for (int i = 0; i < NKC; ++i) { const int c = tid + 256 * i, kr = c / (DQK / 8), kc = c % (DQK / 8); kreg[i] = *(const u32x4*)(Kp + (size_t)(pn + kr) * DQK + kc * 8); }
#pragma unroll
      for (int i = 0; i < 2; ++i) { const int c = tid + 256 * i, d = c >> 3, kc = c & 7; vreg[i] = *(const u32x4*)(VTp + (size_t)d * SA + pn + kc * 8); }
    }
    __builtin_amdgcn_sched_barrier(0);
    f32x16 s[2];
#pragma unroll
    for (int i = 0; i < 16; ++i) { s[0][i] = 0.f; s[1][i] = 0.f; }
#pragma unroll
    for (int mt = 0; mt < 2; ++mt)
#pragma unroll
      for (int ks = 0; ks < NKS; ++ks) {
        bf16x8 a = *(const bf16x8*)(sK + (mt * 32 + r) * KS + ks * 16 + h * 8);
        s[mt] = MFMA(a, qf[ks], s[mt]);
      }
    if (masked && tt >= n1) {
      const int kbase = pos - CTX;
#pragma unroll
      for (int mt = 0; mt < 2; ++mt)
#pragma unroll
        for (int i = 0; i < 16; ++i) {
          const int kp = kbase + mt * 32 + crow(i, h);
          const int dlt = qpos - kp;
          if (dlt > 128 || dlt < -128) s[mt][i] = -INFINITY;
        }
    }
    if (NOMAX) {
      float rs = 0.f;
#pragma unroll
      for (int mt = 0; mt < 2; ++mt)
#pragma unroll
        for (int i = 0; i < 16; ++i) { const float p = __builtin_amdgcn_exp2f(s[mt][i]); s[mt][i] = p; rs += p; }
      lsum += rs;
    } else {
    float mx = s[0][0];
#pragma unroll
    for (int i = 1; i < 16; ++i) mx = fmaxf(mx, s[0][i]);
#pragma unroll
    for (int i = 0; i < 16; ++i) mx = fmaxf(mx, s[1][i]);
    mx = fmaxf(mx, __shfl_xor(mx, 32));
    const float mn = fmaxf(m, mx);
    const float alpha = __builtin_amdgcn_exp2f(m - mn);
    float rs = 0.f;
#pragma unroll
    for (int mt = 0; mt < 2; ++mt)
#pragma unroll
      for (int i = 0; i < 16; ++i) { const float p = __builtin_amdgcn_exp2f(s[mt][i] - mn); s[mt][i] = p; rs += p; }
    lsum = lsum * alpha + rs;
    if (__ballot(mn != m) != 0ull) {
#pragma unroll
      for (int i = 0; i < 16; ++i) { o[0][i] *= alpha; o[1][i] *= alpha; }
    }
    m = mn;
    }
#pragma unroll
    for (int s2 = 0; s2 < 4; ++s2) {
      const int mt = s2 >> 1, ss = s2 & 1;
      u32x4 pb;
#pragma unroll
      for (int j = 0; j < 4; ++j) pb[j] = pack2(s[mt][8 * ss + 2 * j], s[mt][8 * ss + 2 * j + 1]);
      const bf16x8 bfrag = __builtin_bit_cast(bf16x8, pb);
#pragma unroll
      for (int mt2 = 0; mt2 < 2; ++mt2) {
        const bfu* vp = sV + (mt2 * 32 + r) * VS + 32 * mt + 16 * ss + 4 * h;
        bf16x4 lo = *(const bf16x4*)vp, hi = *(const bf16x4*)(vp + 8);
        const bf16x8 a = __builtin_shufflevector(lo, hi, 0, 1, 2, 3, 4, 5, 6, 7);
        o[mt2] = MFMA(a, bfrag, o[mt2]);
      }
    }
  }
  const float ltot = lsum + __shfl_xor(lsum, 32);
  const float inv = 1.f / ltot;
  bfu* orow = Op + (size_t)(wave * 32 + r) * D;
#pragma unroll
  for (int mt2 = 0; mt2 < 2; ++mt2)
#pragma unroll
    for (int g = 0; g < 4; ++g) {
      u32x2 q; q[0] = pack2(o[mt2][4 * g] * inv, o[mt2][4 * g + 1] * inv); q[1] = pack2(o[mt2][4 * g + 2] * inv, o[mt2][4 * g + 3] * inv);
      *(u32x2*)(orow + mt2 * 32 + 8 * g + 4 * h) = q;
    }
}

DI int chunk_row0(int b, int oc) { return oc < 2 ? TL + b * CTX + oc * 128 : b * SEQ + (oc - 2) * 128; }

DI void ssd_state_item(const Params& P, int l, int id, char* lds) {
  const int hd = id & 3, oc = (id >> 2) % NCH, dir = (id / (4 * NCH)) & 1, b = id / (8 * NCH);
  int tid = threadIdx.x; asm volatile("" : "+v"(tid));
  const int lane = tid & 63, wave = tid >> 6, r = lane & 31, h = lane >> 5;
  bfu* sX = (bfu*)lds;
  float* sW = (float*)(lds + 64 * 136 * 2);
  const int grow0 = chunk_row0(b, oc), pos0 = oc * 128, g = hd >> 1, col = dir * 4 + hd;
  const float* DT = (const float*)(P.ws + OFF_DT); const float* CS = (const float*)(P.ws + OFF_CS);
  __syncthreads();
  if (tid < 128) {
    const float cs = CS[(size_t)(grow0 + tid) * 8 + col], dt = DT[(size_t)(grow0 + tid) * 8 + col];
    const float tot = CS[(size_t)(grow0 + 127) * 8 + col];
    const float a_neg = -__expf(P.in[I_ALOG][l * 8 + col]);
    sW[tid] = dir == 0 ? dt * __expf(tot - cs) : dt * __expf(cs - dt * a_neg);
  }
  __syncthreads();
  const bfu* XT = (const bfu*)(P.ws + OFF_XT) + ((size_t)(b * 4 + hd) * 64) * SA + pos0;
#pragma unroll
  for (int i = 0; i < 4; ++i) {
    const int c = tid + 256 * i, p = c >> 4, j8 = (c & 15) * 8;
    u32x4 u = *(const u32x4*)(XT + (size_t)p * SA + j8);
    u32x4 q;
#pragma unroll
    for (int j = 0; j < 4; ++j) q[j] = pack2(bflo(u[j]) * sW[j8 + 2 * j], bfhi(u[j]) * sW[j8 + 2 * j + 1]);
    *(u32x4*)(sX + p * 136 + j8) = q;
  }
  __syncthreads();
  f32x16 acc[2];
#pragma unroll
  for (int i = 0; i < 16; ++i) { acc[0][i] = 0.f; acc[1][i] = 0.f; }
  const bfu* BT = (const bfu*)(P.ws + OFF_BT) + ((size_t)(b * 2 + g) * 128 + wave * 32 + r) * SA + pos0 + h * 8;
  bf16x8 bbv[8];
#pragma unroll
  for (int s = 0; s < 8; ++s) bbv[s] = *(const bf16x8*)(BT + s * 16);
  __builtin_amdgcn_sched_barrier(0);
#pragma unroll
  for (int s = 0; s < 8; ++s) {
#pragma unroll
    for (int mt = 0; mt < 2; ++mt) {
      const bf16x8 a = *(const bf16x8*)(sX + (mt * 32 + r) * 136 + s * 16 + h * 8);
      acc[mt] = MFMA(a, bbv[s], acc[mt]);
    }
  }
  bfu* ST = (bfu*)(P.ws + OFF_ST) + ((size_t)((b * 2 + dir) * NCH + oc) * 4 + hd) * 8192;
#pragma unroll
  for (int mt = 0; mt < 2; ++mt)
#pragma unroll
    for (int i = 0; i < 16; ++i) ST[(mt * 32 + crow(i, h)) * 128 + wave * 32 + r] = f2bf(acc[mt][i]);
}

DI void phase_scan(const Params& P) {
  const float* CS = (const float*)(P.ws + OFF_CS);
  const int total = NB * 2 * 4 * 1024;
  for (int u = blockIdx.x * 256 + threadIdx.x; u < total; u += gridDim.x * 256) {
    const int e8 = u & 1023, hd = (u >> 10) & 3, dir = (u >> 12) & 1, b = u >> 13;
    bfu* base = (bfu*)(P.ws + OFF_ST) + ((size_t)(b * 2 + dir) * NCH * 4 + hd) * 8192 + e8 * 8;
    u32x4 st[NCH]; float dec[NCH];
#pragma unroll
    for (int step = 0; step < NCH; ++step) {
      const int oc = dir == 0 ? step : (step < 2 ? 1 - step : 19 - step);
      st[step] = *(const u32x4*)(base + (size_t)oc * 4 * 8192);
      dec[step] = CS[(size_t)(chunk_row0(b, oc) + 127) * 8 + dir * 4 + hd];
    }
    __builtin_amdgcn_sched_barrier(0);
    float hs[8];
#pragma unroll
    for (int j = 0; j < 8; ++j) hs[j] = 0.f;
#pragma unroll
    for (int step = 0; step < NCH; ++step) {
      const int oc = dir == 0 ? step : (step < 2 ? 1 - step : 19 - step);
      u32x4 o;
#pragma unroll
      for (int j = 0; j < 4; ++j) o[j] = pack2(hs[2 * j], hs[2 * j + 1]);
      *(u32x4*)(base + (size_t)oc * 4 * 8192) = o;
      const float d = __expf(dec[step]);
#pragma unroll
      for (int j = 0; j < 4; ++j) { hs[2 * j] = d * hs[2 * j] + bflo(st[step][j]); hs[2 * j + 1] = d * hs[2 * j + 1] + bfhi(st[step][j]); }
    }
  }
}

DI void ssd_y_item(const Params& P, int l, int b, int oc, int hd, char* lds) {
  int tid = threadIdx.x; asm volatile("" : "+v"(tid));
  const int lane = tid & 63, wave = tid >> 6, r = lane & 31, h = lane >> 5;
  bfu* sB = (bfu*)lds;
  bfu* sX = sB + 128 * 136;
  float* sF = (float*)(sX + 64 * 136);
  const int grow0 = chunk_row0(b, oc), pos0 = oc * 128, g = hd >> 1;
  const float* DT = (const float*)(P.ws + OFF_DT); const float* CS = (const float*)(P.ws + OFF_CS);
  const float anb = -__expf(P.in[I_ALOG][l * 8 + 4 + hd]);
  __syncthreads();
  if (tid < 128) {
    const size_t o = (size_t)(grow0 + tid) * 8;
    const float csf = CS[o + hd], dtf = DT[o + hd], csb = CS[o + 4 + hd], dtb = DT[o + 4 + hd];
    sF[tid] = csf; sF[128 + tid] = csb - dtb * anb; sF[256 + tid] = dtf; sF[384 + tid] = dtb;
  }
  const float totb = CS[(size_t)(grow0 + 127) * 8 + 4 + hd];
  {
    const bfu* BMp = (const bfu*)(P.ws + OFF_BM) + ((size_t)(b * 2 + g) * SA + pos0) * 128;
#pragma unroll
    for (int i = 0; i < 8; ++i) { const int c = tid + 256 * i, j = c >> 4, n8 = (c & 15) * 8; *(u32x4*)(sB + j * 136 + n8) = *(const u32x4*)(BMp + (size_t)j * 128 + n8); }
    const bfu* XT = (const bfu*)(P.ws + OFF_XT) + ((size_t)(b * 4 + hd) * 64) * SA + pos0;
#pragma unroll
    for (int i = 0; i < 4; ++i) { const int c = tid + 256 * i, p = c >> 4, j8 = (c & 15) * 8; *(u32x4*)(sX + p * 136 + j8) = *(const u32x4*)(XT + (size_t)p * SA + j8); }
  }
  __syncthreads();
  const int qi = wave * 32 + r;
  bf16x8 cf[8];
  {
    const bfu* CMp = (const bfu*)(P.ws + OFF_CM) + ((size_t)(b * 2 + g) * SA + pos0 + qi) * 128 + h * 8;
#pragma unroll
    for (int s = 0; s < 8; ++s) cf[s] = *(const bf16x8*)(CMp + s * 16);
  }
  f32x16 g4[4];
#pragma unroll
  for (int mt = 0; mt < 4; ++mt) {
#pragma unroll
    for (int i = 0; i < 16; ++i) g4[mt][i] = 0.f;
#pragma unroll
    for (int s = 0; s < 8; ++s) {
      const bf16x8 a = *(const bf16x8*)(sB + (mt * 32 + r) * 136 + s * 16 + h * 8);
      g4[mt] = MFMA(a, cf[s], g4[mt]);
    }
  }
  const float my_csf = sF[qi], my_eb = sF[128 + qi];
#pragma unroll
  for (int mt = 0; mt < 4; ++mt)
#pragma unroll
    for (int i = 0; i < 16; ++i) {
      const int j = mt * 32 + crow(i, h);
      float f = 0.f;
      if (j <= qi) f += __expf(my_csf - sF[j]) * sF[256 + j];
      if (j >= qi) f += __expf(sF[128 + j] - my_eb) * sF[384 + j];
      g4[mt][i] *= f;
    }
  f32x16 y[2];
#pragma unroll
  for (int i = 0; i < 16; ++i) { y[0][i] = 0.f; y[1][i] = 0.f; }
#pragma unroll
  for (int s2 = 0; s2 < 8; ++s2) {
    const int mt = s2 >> 1, ss = s2 & 1;
    u32x4 pb;
#pragma unroll
    for (int j = 0; j < 4; ++j) pb[j] = pack2(g4[mt][8 * ss + 2 * j], g4[mt][8 * ss + 2 * j + 1]);
    const bf16x8 bfrag = __builtin_bit_cast(bf16x8, pb);
#pragma unroll
    for (int mt2 = 0; mt2 < 2; ++mt2) {
      const bfu* vp = sX + (mt2 * 32 + r) * 136 + 32 * mt + 16 * ss + 4 * h;
      bf16x4 lo = *(const bf16x4*)vp, hi = *(const bf16x4*)(vp + 8);
      const bf16x8 a = __builtin_shufflevector(lo, hi, 0, 1, 2, 3, 4, 5, 6, 7);
      y[mt2] = MFMA(a, bfrag, y[mt2]);
    }
  }
#pragma unroll
  for (int dir = 0; dir < 2; ++dir) {
    f32x16 tmp[2];
#pragma unroll
    for (int i = 0; i < 16; ++i) { tmp[0][i] = 0.f; tmp[1][i] = 0.f; }
    const bfu* hin = (const bfu*)(P.ws + OFF_ST) + ((size_t)((b * 2 + dir) * NCH + oc) * 4 + hd) * 8192 + h * 8;
#pragma unroll
    for (int mt2 = 0; mt2 < 2; ++mt2) {
      bf16x8 hv[8];
#pragma unroll
      for (int s = 0; s < 8; ++s) hv[s] = *(const bf16x8*)(hin + (mt2 * 32 + r) * 128 + s * 16);
      __builtin_amdgcn_sched_barrier(0);
#pragma unroll
      for (int s = 0; s < 8; ++s) tmp[mt2] = MFMA(hv[s], cf[s], tmp[mt2]);
    }
    const float sc = dir == 0 ? __expf(my_csf) : __expf(totb - my_eb);
#pragma unroll
    for (int i = 0; i < 16; ++i) { y[0][i] += sc * tmp[0][i]; y[1][i] += sc * tmp[1][i]; }
  }
  const float skip = P.in[I_SKIP][l * 4 + hd];
  const int grow = grow0 + qi;
  const bfu* Zr = (const bfu*)(P.ws + OFF_Z) + (size_t)grow * 256 + hd * 64;
  bfu* Or = (bfu*)(P.ws + OFF_NBUF) + (size_t)grow * D + 768 + hd * 64;
  float ss = 0.f;
#pragma unroll
  for (int mt2 = 0; mt2 < 2; ++mt2)
#pragma unroll
    for (int gq = 0; gq < 4; ++gq) {
      const int p0 = mt2 * 32 + 8 * gq + 4 * h;
      const u32x2 zz = *(const u32x2*)(Zr + p0);
      float u4[4];
#pragma unroll
      for (int j = 0; j < 4; ++j) {
        const float x = bf2f(sX[(p0 + j) * 136 + qi]);
        const float z = (j & 1) ? bfhi(zz[j >> 1]) : bflo(zz[j >> 1]);
        const float u = (y[mt2][4 * gq + j] + skip * x) * silu_f(z);
        u4[j] = u; ss += u * u;
      }
      u32x2 q; q[0] = pack2(u4[0], u4[1]); q[1] = pack2(u4[2], u4[3]);
      *(u32x2*)(Or + p0) = q;
    }
  ss += __shfl_xor(ss, 32);
  if (h == 0) ((float*)(P.ws + OFF_ROWSS))[(size_t)grow * 4 + hd] = ss;
}

DI void phase_ssd_y(const Params& P, int l, char* lds) {
  const int oc_lo = l == 0 ? 0 : 2, noc = NCH - oc_lo;
  const int total = NB * noc * 4;
  for (int it = blockIdx.x; it < total; it += gridDim.x) {
    const int hd = it & 3, oc = oc_lo + (it >> 2) % noc, b = (it >> 2) / noc;
    ssd_y_item(P, l, b, oc, hd, lds);
  }
}

template <int MODE>
DI void phase_attn(const Params& P, int l, char* lds) {
  const int nB = MODE == 1 ? 512 : 0, nC = MODE == 0 ? 512 : 0, nA = MODE == 2 ? 512 : 0;
  const int nS = MODE == 0 ? NB * 2 * NCH * 4 : 0, nX = (MODE == 0 && l == 0) ? 192 : 0;
  const int total = nB + nC + nA + nS + nX;
  bfu* O = (bfu*)(P.ws + OFF_NBUF);
  bool nomaxB = false;
  if (MODE == 1) {
    float gq = fabsf(P.in[I_BQN][l * 64 + (threadIdx.x & 63)]), gk = fabsf(P.in[I_BKN][l * 64 + (threadIdx.x & 63)]);
#pragma unroll
    for (int o_ = 32; o_ >= 1; o_ >>= 1) { gq = fmaxf(gq, __shfl_xor(gq, o_)); gk = fmaxf(gk, __shfl_xor(gk, o_)); }
    nomaxB = gq * gk * 11.6f < 100.f;
  }
  for (int k_ = 0, it = tile_at(0, total); it >= 0; ++k_, it = tile_at(k_, total)) {
    if (it < nB + nC + nA) {
      const int mixer = it < nB ? 1 : (it < nB + nC ? 2 : 0);
      const int id = it < nB ? it : (it < nB + nC ? it - nB : it - nB - nC);
      const int b = id >> 6, hq = (id >> 4) & 3, qb = id & 15;
      const int q0 = qb * 128;
      bfu* Op = O + (size_t)(b * SEQ + q0) * D + (mixer == 0 ? 0 : (mixer == 1 ? 256 : 512)) + hq * 64;
      if (mixer == 1) {
        const bfu* Qp = (const bfu*)(P.ws + OFF_QB) + ((size_t)(b * 4 + hq) * SA + CTX + q0) * 64;
        const bfu* Kp = (const bfu*)(P.ws + OFF_KB) + (size_t)(b * 2 + (hq >> 1)) * SA * 64;
        const bfu* Vp = (const bfu*)(P.ws + OFF_VTB) + (size_t)(b * 2 + (hq >> 1)) * 64 * SA;
        if (nomaxB) attn_item<64, true>(Qp, Kp, Vp, 36, 0, 0, 0, false, 0, false, 0.f, Op, lds);
        else attn_item<64>(Qp, Kp, Vp, 36, 0, 0, 0, false, 0, false, 0.f, Op, lds);
      } else if (mixer == 2) {
        const bfu* Qp = (const bfu*)(P.ws + OFF_QC) + ((size_t)(b * 4 + hq) * SA + CTX + q0) * 96;
        const bfu* Kp = (const bfu*)(P.ws + OFF_KC) + (size_t)(b * 4 + hq) * SA * 96;
        const bfu* Vp = (const bfu*)(P.ws + OFF_VTC) + (size_t)(b * 4 + hq) * 64 * SA;
        attn_item<96>(Qp, Kp, Vp, 36, 0, 0, 0, false, 0, false, 0.f, Op, lds);
      } else {
        const bfu* Qp = (const bfu*)(P.ws + OFF_QA) + ((size_t)(b * 4 + hq) * SA + CTX + q0) * 64;
        const bfu* Kp = (const bfu*)(P.ws + OFF_KA) + (size_t)(b * 2 + (hq >> 1)) * SA * 64;
        const bfu* Vp = (const bfu*)(P.ws + OFF_VTA) + (size_t)(b * 2 + (hq >> 1)) * 64 * SA;
        const int lo = q0 - 128 < 0 ? 0 : q0 - 128, hi = q0 + 256 > SEQ ? SEQ : q0 + 256;
        attn_item<64>(Qp, Kp, Vp, 4, 0, (hi - lo) >> 6, CTX + lo, true, q0, true, P.in[I_SINK][l * 4 + hq], Op, lds);
      }
    } else if (it < nB + nC + nA + nS) {
      ssd_state_item(P, l, it - (nB + nC + nA), lds);
    } else {
      const int id = it - (nB + nC + nA + nS);
      const int mixer = id >> 6, b = (id >> 3) & 7, hq = (id >> 1) & 3, qb = id & 1;
      const int q0 = qb * 128;
      bfu* Op = O + (size_t)(TL + b * CTX + q0) * D + mixer * 256 + hq * 64;
      if (mixer == 2) {
        const bfu* Qp = (const bfu*)(P.ws + OFF_QC) + ((size_t)(b * 4 + hq) * SA + q0) * 96;
        const bfu* Kp = (const bfu*)(P.ws + OFF_KC) + (size_t)(b * 4 + hq) * SA * 96;
        const bfu* Vp = (const bfu*)(P.ws + OFF_VTC) + (size_t)(b * 4 + hq) * 64 * SA;
        attn_item<96>(Qp, Kp, Vp, 4, 0, 0, 0, false, 0, false, 0.f, Op, lds);
      } else {
        const bfu* Qp = (const bfu*)(P.ws + (mixer ? OFF_QB : OFF_QA)) + ((size_t)(b * 4 + hq) * SA + q0) * 64;
        const bfu* Kp = (const bfu*)(P.ws + (mixer ? OFF_KB : OFF_KA)) + (size_t)(b * 2 + (hq >> 1)) * SA * 64;
        const bfu* Vp = (const bfu*)(P.ws + (mixer ? OFF_VTB : OFF_VTA)) + (size_t)(b * 2 + (hq >> 1)) * 64 * SA;
        attn_item<64>(Qp, Kp, Vp, 4, 0, 0, 0, false, 0, mixer == 0, mixer == 0 ? P.in[I_SINK][l * 4 + hq] : 0.f, Op, lds);
      }
    }
  }
}


#define XB_TMO      128
#define XB_XCNT(j)  (256  + 64 * (j))
#define XB_XSUB(j)  (1280 + 64 * (j))
#define XB_XGEN(j)  (2304 + 64 * (j))
#define XB_TOP      3328
#define XB_TOPGEN   3392
#define XCD_BAR_WORDS 3456
#define XB_SPIN_CAP (1u << 18)
#define LAS __attribute__((address_space(3)))
DI unsigned xb_ld(unsigned* p)              { return __hip_atomic_load(p, __ATOMIC_RELAXED, __HIP_MEMORY_SCOPE_AGENT); }
DI unsigned xb_add(unsigned* p, unsigned v) { return __hip_atomic_fetch_add(p, v, __ATOMIC_RELAXED, __HIP_MEMORY_SCOPE_AGENT); }
DI unsigned xb_xcc_id() { return (unsigned)__builtin_amdgcn_s_getreg((3 << 11) | 20) & 0xFu; }
#define XB_SPIN(cond, bar) do { unsigned _sp = 0; while (cond) { __builtin_amdgcn_s_sleep(1); \
    if ((++_sp & 255u) == 0u) { if (xb_ld(&(bar)[XB_TMO])) break; if (_sp > XB_SPIN_CAP) { atomicAdd(&(bar)[XB_TMO], 1u); break; } } } } while (0)
struct XcdBarrier { unsigned* bar; unsigned x; volatile LAS unsigned* st; };
DI XcdBarrier xcd_barrier_post(unsigned* bar, volatile LAS unsigned* st) {
  XcdBarrier b; b.bar = bar; b.x = xb_xcc_id(); b.st = st;
  if (threadIdx.x == 0) (void)xb_add(&bar[XB_XCNT(b.x)], 1u);
  return b;
}
DI void xcd_barrier_complete(unsigned* bar, unsigned x, unsigned& nloc, unsigned& nx) {
  const unsigned G = gridDim.x * gridDim.y * gridDim.z;
  unsigned sum, cnt, mine, sp = 0u;
  for (;;) {
    sum = 0u; cnt = 0u; mine = 0u;
#pragma unroll
    for (unsigned j = 0; j < 16; ++j) { const unsigned c = xb_ld(&bar[XB_XCNT(j)]); sum += c; cnt += (c > 0u) ? 1u : 0u; mine = (j == x) ? c : mine; }
    if (sum == G) break;
    __builtin_amdgcn_s_sleep(1);
    if ((++sp & 255u) == 0u) { if (xb_ld(&bar[XB_TMO])) break; if (sp > XB_SPIN_CAP) { atomicAdd(&bar[XB_TMO], 1u); break; } }
  }
  nloc = mine > 0u ? mine : 1u; nx = cnt > 0u ? cnt : 1u;
}
DI void xcd_barrier(const XcdBarrier& b) {
  asm volatile("s_waitcnt vmcnt(0)" ::: "memory");
  __syncthreads();
  if (threadIdx.x == 0) {
    unsigned* bar = b.bar;
    __builtin_amdgcn_s_waitcnt(0);
    unsigned nloc = b.st[0], nx = b.st[1];
    if (nloc == 0u) { xcd_barrier_complete(bar, b.x, nloc, nx); b.st[0] = nloc; b.st[1] = nx; }
    const unsigned old = xb_add(&bar[XB_XSUB(b.x)], 1u);
    const unsigned gen = old / nloc;
    if (old + 1u == (gen + 1u) * nloc) {
      __builtin_amdgcn_fence(__ATOMIC_RELEASE, "agent");
      asm volatile("s_waitcnt vmcnt(0)" ::: "memory");
      const unsigned og = xb_add(&bar[XB_TOP], 1u);
      const unsigned tg = og / nx;
      if (og + 1u == (tg + 1u) * nx) xb_add(&bar[XB_TOPGEN], 1u);
      else XB_SPIN(xb_ld(&bar[XB_TOPGEN]) == tg, bar);
      __builtin_amdgcn_fence(__ATOMIC_ACQUIRE, "agent");
      xb_add(&bar[XB_XGEN(b.x)], 1u);
      asm volatile("s_waitcnt vmcnt(0)" ::: "memory");
    } else {
      XB_SPIN(xb_ld(&bar[XB_XGEN(b.x)]) == gen, bar);
      __builtin_amdgcn_fence(__ATOMIC_ACQUIRE, "agent");
      asm volatile("s_waitcnt vmcnt(0)" ::: "memory");
    }
  }
  __syncthreads();
}

constexpr int PH_PER_LAYER = 14;
constexpr int N_PHASES = 2 * PH_PER_LAYER + 1;

template <int L>
DI void run_layer(const Params& P, const XcdBarrier& bar, char* lds, unsigned long long& tacc) {
  const bfu* Wb = (const bfu*)(P.ws + woff(L));
  const float* hc = (const float*)(P.ws + OFF_HC);
  constexpr int M2 = L == 0 ? T : TL;
  const float* s_lat = L == 0 ? P.in[I_X] : P.out;
  const float* s_ctx = L == 0 ? P.in[I_CTX] : hc;
  const int lo = P.ph_lo, hi = P.ph_hi;
#ifndef REP_MASK
#define REP_MASK 0
#endif
#ifndef REP_L
#define REP_L -1
#endif
#define PH(k, body) { const int ph_ = L * PH_PER_LAYER + (k); unsigned long long t0_ = 0; if ((TIMEMASK >> (k)) & 1) t0_ = __builtin_amdgcn_s_memrealtime(); if (lo <= ph_ && ph_ < hi) { body; if (((REP_MASK >> (k)) & 1) && (REP_L < 0 || REP_L == L)) { xcd_barrier(bar); body; } if (ph_ + 1 < hi) xcd_barrier(bar); } if ((TIMEMASK >> (k)) & 1) tacc += __builtin_amdgcn_s_memrealtime() - t0_; }
  if (L == 0) PH(0, phase_convert(P, 0, lds, 0, 704, 0))
  PH(1, phase_norm(P, L, s_lat, s_ctx, P.in[I_F1N] + L * D, 0, 1, T, ((1 + L) & 1) == 0))
  PH(2, { const bool up2_ = (int)blockIdx.x * 2 >= (int)gridDim.x;
          if (L == 0 && up2_) phase_convert(P, 0, lds, 704, 1 << 30, -1);
          phase_gemm_swiglu(P, Wb + W_WI1, T, ((2 + L) & 1) == 0, lds);
          if (L == 0 && !up2_) phase_convert(P, 0, lds, 704, 1 << 30, -1); })
  PH(3, phase_gemm_resid(P, L, (const bfu*)(P.ws + OFF_ACT), FFN, Wb + W_WO1, T, 2, 0.5f, s_lat, s_ctx, 0, nullptr, ((3 + L) & 1) == 0, lds))
  PH(4, phase_norm(P, L, P.out, hc, P.in[I_MIXN] + L * D, 3, 4, T, ((4 + L) & 1) == 0))
  PH(5, phase_gemm_win(P, L, ((5 + L) & 1) == 0, lds))
  PH(6, phase_mla_conv(P, L, lds))
  PH(7, phase_attn<0>(P, L, lds))
  PH(8, { phase_scan(P);
          const bool upper_ = (int)blockIdx.x * 2 >= (int)gridDim.x;
          if (L == 0 && upper_) phase_convert(P, 1, lds, 0, 1 << 30, 1);
          phase_attn<1>(P, L, lds);
          if (L == 0 && !upper_) phase_convert(P, 1, lds, 0, 1 << 30, 1); })
  PH(9, { phase_attn<2>(P, L, lds); phase_ssd_y(P, L, lds); })
  PH(10, phase_gemm_resid(P, L, (const bfu*)(P.ws + OFF_NBUF), D, Wb + W_WOUT, M2, 5, 1.0f, P.out, hc, 12, (const float*)(P.ws + OFF_ROWSS), ((10 + L) & 1) == 0, lds))
  PH(11, phase_norm(P, L, P.out, hc, P.in[I_F2N] + L * D, 6, 7, M2, ((11 + L) & 1) == 0))
  PH(12, phase_gemm_swiglu(P, Wb + W_WI2, M2, ((12 + L) & 1) == 0, lds))
  PH(13, phase_gemm_resid(P, L, (const bfu*)(P.ws + OFF_ACT), FFN, Wb + W_WO2, M2, 8, 0.5f, P.out, hc, 0, nullptr, ((13 + L) & 1) == 0, lds))
#undef PH
}

__global__ void __launch_bounds__(256, 2) fwd_kernel(Params P) {
  extern __shared__ __attribute__((aligned(16))) char lds[];
  __shared__ uint4 xb_words;
  cg::grid_group grid = cg::this_grid();
  if (threadIdx.x == 0) xb_words = make_uint4(0u, 0u, 0u, 0u);
  __syncthreads();
  XcdBarrier bar = xcd_barrier_post((unsigned*)(P.ws + OFF_BAR), (volatile LAS unsigned*)&xb_words);
  if (P.ph_hi > 1000) grid.sync();
  unsigned long long tacc = 0;
  run_layer<0>(P, bar, lds, tacc);
  run_layer<1>(P, bar, lds, tacc);
  if (TIMEMASK != 0) { if (blockIdx.x == 0 && threadIdx.x == 0) *(float*)(P.ws + 14336) = (float)tacc * TIMESCALE; xcd_barrier(bar); }
  if (P.ph_lo <= N_PHASES - 1 && N_PHASES - 1 < P.ph_hi) phase_final(P);
}

extern "C" void kernel_launch(void* const* d_in, const int* in_sizes, int n_in, void* d_out, int out_size, void* d_ws, size_t ws_size,
                              hipStream_t stream) {
  static int grid_blocks = 0;
  if (grid_blocks == 0) {
    if (ws_size < OFF_END) { fprintf(stderr, "kernel_launch: workspace too small: %zu < %zu\n", ws_size, (size_t)OFF_END); grid_blocks = -1; return; }
    int dev = 0, cus = 0, per_cu = 0;
    (void)hipGetDevice(&dev);
    (void)hipDeviceGetAttribute(&cus, hipDeviceAttributeMultiprocessorCount, dev);
    if (hipFuncSetAttribute((const void*)fwd_kernel, hipFuncAttributeMaxDynamicSharedMemorySize, LDS_BYTES) != hipSuccess) {
      fprintf(stderr, "kernel_launch: hipFuncSetAttribute failed\n"); grid_blocks = -1; return; }
    (void)hipOccupancyMaxActiveBlocksPerMultiprocessor(&per_cu, (const void*)fwd_kernel, 256, LDS_BYTES);
    if (per_cu < 1) { fprintf(stderr, "kernel_launch: occupancy query returned %d\n", per_cu); grid_blocks = -1; return; }
    if (per_cu > 2) per_cu = 2;
    grid_blocks = cus * per_cu;
    fprintf(stderr, "kernel_launch: grid %d (%d per CU), ws need %zu have %zu\n", grid_blocks, per_cu, (size_t)OFF_END, ws_size);
  }
  if (grid_blocks < 0) return;
  Params p{};
  for (int i = 0; i < 29; ++i) p.in[i] = (const float*)d_in[i];
  p.out = (float*)d_out; p.ws = (unsigned char*)d_ws;
#if MULTI_LAUNCH
  for (int ph = 0; ph < N_PHASES; ++ph) {
    (void)hipMemsetAsync(d_ws, 0, 16384, stream);
    p.ph_lo = ph; p.ph_hi = ph + 1;
    void* args[] = {&p};
    (void)hipLaunchCooperativeKernel((const void*)fwd_kernel, dim3(grid_blocks), dim3(256), args, LDS_BYTES, stream);
  }
#else
  (void)hipMemsetAsync(d_ws, 0, 16384, stream);
  p.ph_lo = 0; p.ph_hi = N_PHASES;
  void* args[] = {&p};
  hipError_t e = hipLaunchCooperativeKernel((const void*)fwd_kernel, dim3(grid_blocks), dim3(256), args, LDS_BYTES, stream);
  if (e != hipSuccess) fprintf(stderr, "cooperative launch failed: %s (grid %d)\n", hipGetErrorString(e), grid_blocks);
#endif
}
```

```cpp
#include <hip/hip_runtime.h>
#include <hip/hip_cooperative_groups.h>
#include <cstdio>
namespace cg = cooperative_groups;

#ifndef TIMEMASK
#define TIMEMASK 0
#endif
#ifndef TIMESCALE
#define TIMESCALE 1e-7f
#endif
#ifndef MULTI_LAUNCH
#define MULTI_LAUNCH 0
#endif

#define DI __device__ __forceinline__
typedef unsigned short bfu;
typedef __attribute__((ext_vector_type(8))) short bf16x8;
typedef __attribute__((ext_vector_type(4))) short bf16x4;
typedef __attribute__((ext_vector_type(16))) float f32x16;
typedef __attribute__((ext_vector_type(2))) __bf16 bf2_t;
typedef __attribute__((ext_vector_type(2))) float f2_t;
typedef __attribute__((ext_vector_type(4))) unsigned u32x4;
typedef __attribute__((ext_vector_type(2))) unsigned u32x2;

#define MFMA(a, b, c) __builtin_amdgcn_mfma_f32_32x32x16_bf16((a), (b), (c), 0, 0, 0)

DI unsigned pack2(float a, float b) { f2_t v = {a, b}; return __builtin_bit_cast(unsigned, __builtin_convertvector(v, bf2_t)); }
DI bfu f2bf(float a) { return (bfu)(pack2(a, 0.f) & 0xffffu); }
DI float bf2f(bfu v) { return __uint_as_float(((unsigned)v) << 16); }
DI float bflo(unsigned u) { return __uint_as_float(u << 16); }
DI float bfhi(unsigned u) { return __uint_as_float(u & 0xffff0000u); }
DI int crow(int reg, int h) { return (reg & 3) + 8 * (reg >> 2) + 4 * h; }
DI float silu_f(float x) { return x * __builtin_amdgcn_rcpf(1.f + __builtin_amdgcn_exp2f(-1.4426950408889634f * x)); }

constexpr int D = 1024, SEQ = 2048, CTX = 256, NB = 8, FFN = 2816;
constexpr int TL = NB * SEQ;
constexpr int TC = NB * CTX;
constexpr int T = TL + TC;
constexpr int SA = CTX + SEQ;
constexpr int NWIN = 2688;
constexpr int NMOD = 9 * D;
constexpr float EPS = 1e-6f;
constexpr int NCH = 18;

constexpr size_t al(size_t x) { return (x + 255) & ~(size_t)255; }
constexpr size_t E_WI = (size_t)2 * FFN * D, E_WO = (size_t)D * FFN, E_WIN = (size_t)NWIN * D, E_WOUT = (size_t)D * D;
constexpr size_t E_UQ = 512 * 256, E_UKV = 512 * 128;
constexpr size_t W_WI1 = 0, W_WO1 = W_WI1 + E_WI, W_WIN = W_WO1 + E_WO, W_WOUT = W_WIN + E_WIN, W_WI2 = W_WOUT + E_WOUT,
                 W_WO2 = W_WI2 + E_WI, W_UQ = W_WO2 + E_WO, W_UKV = W_UQ + E_UQ, W_END = W_UKV + E_UKV;
constexpr size_t OFF_BAR = 0;
constexpr size_t OFF_W = 16384;
constexpr size_t OFF_MODS = al(OFF_W + W_END * 2);
constexpr size_t OFF_HC = al(OFF_MODS + (size_t)2 * 9 * NMOD * 4);
constexpr size_t OFF_NBUF = al(OFF_HC + (size_t)TC * D * 4);
constexpr size_t OFF_ROWSS = al(OFF_NBUF + (size_t)T * D * 2);
constexpr size_t OFF_MIX = al(OFF_ROWSS + (size_t)T * 16);
constexpr size_t OFF_ACT = OFF_MIX;
constexpr size_t SZ_Q = (size_t)NB * 4 * SA * 64 * 2, SZ_KV = (size_t)NB * 2 * SA * 64 * 2;
constexpr size_t OFF_QA = OFF_MIX, OFF_KA = al(OFF_QA + SZ_Q), OFF_VTA = al(OFF_KA + SZ_KV);
constexpr size_t OFF_QB = al(OFF_VTA + SZ_KV), OFF_KB = al(OFF_QB + SZ_Q), OFF_VTB = al(OFF_KB + SZ_KV);
constexpr size_t OFF_CQ = al(OFF_VTB + SZ_KV), OFF_CKV = al(OFF_CQ + (size_t)T * 256 * 2);
constexpr size_t OFF_QC = al(OFF_CKV + (size_t)T * 128 * 2), OFF_KC = al(OFF_QC + (size_t)NB * 4 * SA * 96 * 2);
constexpr size_t OFF_VTC = al(OFF_KC + (size_t)NB * 4 * SA * 96 * 2);
constexpr size_t OFF_Z = al(OFF_VTC + (size_t)NB * 4 * 64 * SA * 2), OFF_XBC = al(OFF_Z + (size_t)T * 256 * 2);
constexpr size_t OFF_DT = al(OFF_XBC + (size_t)T * 768 * 2), OFF_CS = al(OFF_DT + (size_t)T * 8 * 4);
constexpr size_t OFF_XT = al(OFF_CS + (size_t)T * 8 * 4), OFF_BM = al(OFF_XT + (size_t)NB * 4 * 64 * SA * 2);
constexpr size_t OFF_BT = al(OFF_BM + (size_t)NB * 2 * SA * 128 * 2), OFF_CM = al(OFF_BT + (size_t)NB * 2 * SA * 128 * 2);
constexpr size_t OFF_ST = OFF_XBC;
static_assert((size_t)NB * 2 * NCH * 4 * 8192 * 2 <= (size_t)T * 768 * 2, "ST fits in XBC");
constexpr size_t OFF_W2 = al(OFF_CM + (size_t)NB * 2 * SA * 128 * 2);
constexpr size_t OFF_END = al(OFF_W2 + W_END * 2);
static_assert(OFF_ACT + (size_t)T * FFN * 2 <= OFF_END, "act alias fits");

constexpr int LDS_BYTES = 75776;

struct Params {
  const float* in[29];
  float* out;
  unsigned char* ws;
  int ph_lo, ph_hi;
};
enum { I_X = 0, I_C, I_CTX, I_CCTX, I_ADAW, I_ADAB, I_F1N, I_F1WI, I_F1WO, I_MIXN, I_WIN, I_WOUT, I_SINK, I_BQN, I_BKN, I_CQN, I_CWUQ,
       I_CKVN, I_CWUKV, I_CONVW, I_CONVB, I_ALOG, I_DTB, I_SKIP, I_ONORM, I_F2N, I_F2WI, I_F2WO, I_FINAL };

DI size_t woff(int l) { return l == 0 ? OFF_W : OFF_W2; }
DI size_t moff(int l) { return OFF_MODS + (size_t)l * 9 * NMOD * 4; }
DI int row_b(int row) { return row < TL ? row / SEQ : (row - TL) / CTX; }
DI int row_pos(int row) { return row < TL ? CTX + row % SEQ : (row - TL) % CTX; }
DI int row_mrow(int row) { return row < TL ? row / SEQ : 8; }

DI int wmap(int wid, int n) {
  if (wid == 0) {
    int bn = n >> 7, wn = (n >> 6) & 1, nt = (n >> 5) & 1, c = n & 31;
    return nt * FFN + bn * 64 + wn * 32 + c;
  } else if (wid == 2) {
    if (n < 1024) return n;
    if (n < 1536) { int c = n - 1024; return c < 416 ? 1024 + c : -1; }
    int c = n - 1536; return c < 1032 ? 1440 + c : -1;
  } else if (wid == 4) {
    int hd = n >> 7, c = n & 127; return c < 96 ? hd * 96 + c : -1;
  }
  return n;
}

DI void conv_weight_tile(const float* __restrict__ W, int K, int N, bfu* __restrict__ Wt, int n0, int k0, int wid,
                         const float* __restrict__ ksc, int ksc_lo, float* sT) {
  const int tid = threadIdx.x;
  float v[32];
#pragma unroll
  for (int i = 0; i < 32; ++i) {
    int idx = tid + 256 * i, kk = idx >> 6, nn = idx & 63;
    int col = wmap(wid, n0 + nn);
    v[i] = col >= 0 ? __builtin_nontemporal_load(W + (size_t)(k0 + kk) * N + col) : 0.f;
  }
#pragma unroll
  for (int i = 0; i < 32; ++i) {
    int idx = tid + 256 * i, kk = idx >> 6, nn = idx & 63;
    float x = v[i];
    if (ksc && (k0 + kk) >= ksc_lo) x *= ksc[k0 + kk - ksc_lo];
    sT[nn * 129 + kk] = x;
  }
  __syncthreads();
#pragma unroll
  for (int i = 0; i < 4; ++i) {
    int idx = tid + 256 * i, nn = idx >> 4, kc = idx & 15;
    const float* s = sT + nn * 129 + kc * 8;
    u32x4 o; o[0] = pack2(s[0], s[1]); o[1] = pack2(s[2], s[3]); o[2] = pack2(s[4], s[5]); o[3] = pack2(s[6], s[7]);
    *(u32x4*)(Wt + (size_t)(n0 + nn) * K + k0 + kc * 8) = o;
  }
  __syncthreads();
}

DI void phase_convert(const Params& P, int l, char* lds, int t_lo, int t_hi, int mods_l) {
  float* sT = (float*)lds;
  bfu* Wb = (bfu*)(P.ws + woff(l));
  __syncthreads();
  const int t_wi = 88 * 8, t_wo = 16 * 22, t_win = 42 * 8, t_wout = 16 * 8, t_uq = 8 * 2, t_ukv = 8 * 1;
  const int c0 = t_wi, c1 = c0 + t_wo, c2 = c1 + t_win, c3 = c2 + t_wout, c4 = c3 + t_wi, c5 = c4 + t_wo, c6 = c5 + t_uq, c7 = c6 + t_ukv;
  if (t_hi > c7) t_hi = c7;
  const int n_mod = mods_l >= 0 ? 288 : 0;
  const int total = (t_hi - t_lo) + n_mod;
  for (int it0 = blockIdx.x; it0 < total; it0 += gridDim.x) {
    const int it = it0 < n_mod ? c7 + it0 : t_lo + it0 - n_mod;
    if (it < c7) {
      const float* W; int K, N, wid, id; bfu* Wt; const float* ksc = nullptr; int ksc_lo = 0; int nkt;
      if (it < c0)      { id = it;      W = P.in[I_F1WI] + (size_t)l * D * 2 * FFN; K = D; N = 2 * FFN; wid = 0; Wt = Wb + W_WI1; }
      else if (it < c1) { id = it - c0; W = P.in[I_F1WO] + (size_t)l * FFN * D; K = FFN; N = D; wid = 1; Wt = Wb + W_WO1; }
      else if (it < c2) { id = it - c1; W = P.in[I_WIN] + (size_t)l * D * 2472; K = D; N = 2472; wid = 2; Wt = Wb + W_WIN; }
      else if (it < c3) { id = it - c2; W = P.in[I_WOUT] + (size_t)l * D * D; K = D; N = D; wid = 3; Wt = Wb + W_WOUT; ksc = P.in[I_ONORM] + l * 256; ksc_lo = 768; }
      else if (it < c4) { id = it - c3; W = P.in[I_F2WI] + (size_t)l * D * 2 * FFN; K = D; N = 2 * FFN; wid = 0; Wt = Wb + W_WI2; }
      else if (it < c5) { id = it - c4; W = P.in[I_F2WO] + (size_t)l * FFN * D; K = FFN; N = D; wid = 1; Wt = Wb + W_WO2; }
      else if (it < c6) { id = it - c5; W = P.in[I_CWUQ] + (size_t)l * 256 * 384; K = 256; N = 384; wid = 4; Wt = Wb + W_UQ; ksc = P.in[I_CQN] + l * 256; }
      else              { id = it - c6; W = P.in[I_CWUKV] + (size_t)l * 128 * 512; K = 128; N = 512; wid = 5; Wt = Wb + W_UKV; ksc = P.in[I_CKVN] + l * 128; }
      nkt = K / 128;
      conv_weight_tile(W, K, N, Wt, (id / nkt) * 64, (id % nkt) * 128, wid, ksc, ksc_lo, sT);
    } else {
      const int id = it - c7, l2 = mods_l, tid = threadIdx.x;
      float* sS = sT;
      float* sR = sT + 9 * 1024;
      for (int i = tid; i < 9 * 1024; i += 256) {
        int rr = i >> 10, k = i & 1023;
        float cv = rr < 8 ? P.in[I_C][rr * 1024 + k] : P.in[I_CCTX][k];
        sS[i] = silu_f(cv);
      }
      __syncthreads();
      const int col = id * 32 + (tid & 31), kq = tid >> 5;
      const float* W = P.in[I_ADAW] + (size_t)l2 * D * NMOD + col;
      float acc[9];
#pragma unroll
      for (int j = 0; j < 9; ++j) acc[j] = 0.f;
      for (int kb = kq * 128; kb < kq * 128 + 128; kb += 32) {
        float w[32];
#pragma unroll
        for (int u = 0; u < 32; ++u) w[u] = __builtin_nontemporal_load(W + (size_t)(kb + u) * NMOD);
#pragma unroll
        for (int u = 0; u < 32; ++u)
#pragma unroll
          for (int j = 0; j < 9; ++j) acc[j] += sS[j * 1024 + kb + u] * w[u];
      }
#pragma unroll
      for (int j = 0; j < 9; ++j) sR[(kq * 9 + j) * 32 + (tid & 31)] = acc[j];
      __syncthreads();
      for (int i = tid; i < 9 * 32; i += 256) {
        int j = i >> 5, cc = i & 31;
        float s = 0.f;
#pragma unroll
        for (int q = 0; q < 8; ++q) s += sR[(q * 9 + j) * 32 + cc];
        int c2_ = id * 32 + cc;
        ((float*)(P.ws + moff(l2)))[j * NMOD + c2_] = s + P.in[I_ADAB][l2 * NMOD + c2_];
      }
      __syncthreads();
    }
  }
}

DI void phase_norm(const Params& P, int l, const float* src_lat, const float* src_ctx, const float* g, int shift_idx, int scale_idx, int M, bool rev) {
  const int lane = threadIdx.x & 63, wave = threadIdx.x >> 6;
  const float* mods = (const float*)(P.ws + moff(l));
  bfu* dst = (bfu*)(P.ws + OFF_NBUF);
  float* rowss = (float*)(P.ws + OFF_ROWSS);
  const int stride = gridDim.x * 4;
  int lrow = blockIdx.x * 4 + wave;
  float4 vn[4];
  if (lrow < M) {
    const int row = rev ? M - 1 - lrow : lrow;
    const float* src = row < TL ? src_lat + (size_t)row * D : src_ctx + (size_t)(row - TL) * D;
#pragma unroll
    for (int i = 0; i < 4; ++i) vn[i] = ((const float4*)src)[lane + 64 * i];
  }
  for (; lrow < M; lrow += stride) {
    const int row = rev ? M - 1 - lrow : lrow;
    float4 v[4]; float ss = 0.f;
#pragma unroll
    for (int i = 0; i < 4; ++i) v[i] = vn[i];
    if (lrow + stride < M) {
      const int nrow = rev ? M - 1 - (lrow + stride) : lrow + stride;
      const float* src = nrow < TL ? src_lat + (size_t)nrow * D : src_ctx + (size_t)(nrow - TL) * D;
#pragma unroll
      for (int i = 0; i < 4; ++i) vn[i] = ((const float4*)src)[lane + 64 * i];
    }
#pragma unroll
    for (int i = 0; i < 4; ++i) ss += v[i].x * v[i].x + v[i].y * v[i].y + v[i].z * v[i].z + v[i].w * v[i].w;
#pragma unroll
    for (int o = 32; o >= 1; o >>= 1) ss += __shfl_xor(ss, o);
    const float r = rsqrtf(ss * (1.f / D) + EPS);
    const float* msh = mods + row_mrow(row) * NMOD + shift_idx * D;
    const float* msc = mods + row_mrow(row) * NMOD + scale_idx * D;
#pragma unroll
    for (int i = 0; i < 4; ++i) {
      const int c = (lane + 64 * i) * 4;
      float4 gg = *(const float4*)(g + c), sh = *(const float4*)(msh + c), sc = *(const float4*)(msc + c);
      float a0 = v[i].x * r * gg.x * (1.f + sc.x) + sh.x, a1 = v[i].y * r * gg.y * (1.f + sc.y) + sh.y;
      float a2 = v[i].z * r * gg.z * (1.f + sc.z) + sh.z, a3 = v[i].w * r * gg.w * (1.f + sc.w) + sh.w;
      u32x2 o; o[0] = pack2(a0, a1); o[1] = pack2(a2, a3);
      *(u32x2*)(dst + (size_t)row * D + c) = o;
    }
  }
}

DI void phase_final(const Params& P) {
  const int lane = threadIdx.x & 63, wave = threadIdx.x >> 6;
  const float* g = P.in[I_FINAL];
  for (int row = blockIdx.x * 4 + wave; row < TL; row += gridDim.x * 4) {
    float* src = P.out + (size_t)row * D;
    float4 v[4]; float ss = 0.f;
#pragma unroll
    for (int i = 0; i < 4; ++i) { v[i] = ((const float4*)src)[lane + 64 * i]; ss += v[i].x * v[i].x + v[i].y * v[i].y + v[i].z * v[i].z + v[i].w * v[i].w; }
#pragma unroll
    for (int o = 32; o >= 1; o >>= 1) ss += __shfl_xor(ss, o);
    const float r = rsqrtf(ss * (1.f / D) + EPS) * (TIMEMASK != 0 ? 1.f + *(const float*)(P.ws + 14336) : 1.f);
#pragma unroll
    for (int i = 0; i < 4; ++i) {
      const int c = (lane + 64 * i) * 4;
      float4 gg = *(const float4*)(g + c);
      float4 o = {v[i].x * r * gg.x, v[i].y * r * gg.y, v[i].z * r * gg.z, v[i].w * r * gg.w};
      ((float4*)src)[lane + 64 * i] = o;
    }
  }
}

constexpr int LDSS = 72;
constexpr int TILE_E = 128 * LDSS;

template <bool DO_WR, bool DO_LD>
DI void gemm_kstep(const bfu* cA, const bfu* cB, const bfu* nA, const bfu* nB, bfu* dA, bfu* dB, const bfu* Ag2, const bfu* Wg2, int lda, int K,
                   u32x4 (&ra)[4], u32x4 (&rb)[4], bf16x8 (&f0)[4], f32x16 (&acc)[2][2]) {
  bf16x8 f1[4];
#define RDF(F, s_) { F[0] = *(const bf16x8*)(cA + (s_) * 16); F[1] = *(const bf16x8*)(cA + 32 * LDSS + (s_) * 16); \
                     F[2] = *(const bf16x8*)(cB + (s_) * 16); F[3] = *(const bf16x8*)(cB + 32 * LDSS + (s_) * 16); }
#define MM(F) { acc[0][0] = MFMA(F[0], F[2], acc[0][0]); acc[0][1] = MFMA(F[0], F[3], acc[0][1]); \
                acc[1][0] = MFMA(F[1], F[2], acc[1][0]); acc[1][1] = MFMA(F[1], F[3], acc[1][1]); }
#define PA(i_) { if (DO_WR) *(u32x4*)(dA + 32 * (i_) * LDSS) = ra[i_]; if (DO_LD) ra[i_] = *(const u32x4*)(Ag2 + (size_t)(32 * (i_)) * lda); }
#define PB(i_) { if (DO_WR) *(u32x4*)(dB + 32 * (i_) * LDSS) = rb[i_]; if (DO_LD) rb[i_] = *(const u32x4*)(Wg2 + (size_t)(32 * (i_)) * K); }
  __builtin_amdgcn_s_setprio(2);
  RDF(f1, 1) MM(f0) PA(0) PB(0) PA(1)
  __builtin_amdgcn_sched_barrier(0);
  RDF(f0, 2) MM(f1) PB(1) PA(2) PB(2)
  __builtin_amdgcn_sched_barrier(0);
  RDF(f1, 3) MM(f0) PA(3) PB(3)
  __builtin_amdgcn_sched_barrier(0);
  __builtin_amdgcn_s_setprio(0);
  __syncthreads();
  if (DO_WR) { f0[0] = *(const bf16x8*)(nA); f0[1] = *(const bf16x8*)(nA + 32 * LDSS); f0[2] = *(const bf16x8*)(nB); f0[3] = *(const bf16x8*)(nB + 32 * LDSS); }
  MM(f1)
  __builtin_amdgcn_sched_barrier(0);
#undef RDF
#undef MM
#undef PA
#undef PB
}

DI void gemm_mainloop_x(const bfu* __restrict__ A, int lda, const bfu* __restrict__ W, int K, int bm, int bn, int kshift,
                        const float* rowss, char* lds, f32x16 (&acc)[2][2], u32x4 (&ra)[4], u32x4 (&rb)[4], bool have_pref, bool has_next, int nbm, int nbn,
                        const float* resp, unsigned reslo, float (&res)[64]) {
  bfu* sA = (bfu*)lds;
  bfu* sB = sA + 2 * TILE_E;
  int tid = threadIdx.x; asm volatile("" : "+v"(tid));
  const int lane = tid & 63, wave = tid >> 6, r = lane & 31, h = lane >> 5;
  const int wm = wave >> 1, wn = wave & 1;
  const int nk = K / 64;
#pragma unroll
  for (int a = 0; a < 2; ++a)
#pragma unroll
    for (int b = 0; b < 2; ++b)
#pragma unroll
      for (int i = 0; i < 16; ++i) acc[a][b][i] = 0.f;
  const bfu* Ag = A + (size_t)(bm * 128 + (tid >> 3)) * lda + (tid & 7) * 8;
  const bfu* Wg = W + (size_t)(bn * 128 + (tid >> 3)) * K + (tid & 7) * 8;
  const int soff = (tid >> 3) * LDSS + (tid & 7) * 8;
  float* sRS = (float*)(lds + 4 * TILE_E * 2);
  if (rowss != nullptr && tid < 128) {
    const float4 r4 = *(const float4*)(rowss + (size_t)(bm * 128 + tid) * 4);
    sRS[tid] = rsqrtf((r4.x + r4.y + r4.z + r4.w) * (1.f / 256.f) + EPS);
  }
  const int k0 = (kshift % nk) * 64;
  {
    if (!have_pref) {
#pragma unroll
      for (int i = 0; i < 4; ++i) { ra[i] = *(const u32x4*)(Ag + (size_t)(32 * i) * lda + k0); rb[i] = *(const u32x4*)(Wg + (size_t)(32 * i) * K + k0); }
    }
#pragma unroll
    for (int i = 0; i < 4; ++i) { *(u32x4*)(sA + soff + 32 * i * LDSS) = ra[i]; *(u32x4*)(sB + soff + 32 * i * LDSS) = rb[i]; }
    const int k1 = ((1 + kshift) % nk) * 64;
#pragma unroll
    for (int i = 0; i < 4; ++i) { ra[i] = *(const u32x4*)(Ag + (size_t)(32 * i) * lda + k1); rb[i] = *(const u32x4*)(Wg + (size_t)(32 * i) * K + k1); }
  }
  __syncthreads();
  const int fo = r * LDSS + h * 8;
  bf16x8 f0[4];
  {
    const bfu* cA = sA + wm * 64 * LDSS + fo; const bfu* cB = sB + wn * 64 * LDSS + fo;
    f0[0] = *(const bf16x8*)(cA); f0[1] = *(const bf16x8*)(cA + 32 * LDSS); f0[2] = *(const bf16x8*)(cB); f0[3] = *(const bf16x8*)(cB + 32 * LDSS);
  }
#define KPTRS(kt_) const int cur = (kt_) & 1; \
    const bfu* cA = sA + cur * TILE_E + wm * 64 * LDSS + fo; const bfu* cB = sB + cur * TILE_E + wn * 64 * LDSS + fo; \
    const bfu* nA = sA + (cur ^ 1) * TILE_E + wm * 64 * LDSS + fo; const bfu* nB = sB + (cur ^ 1) * TILE_E + wn * 64 * LDSS + fo; \
    bfu* dA = sA + (cur ^ 1) * TILE_E + soff; bfu* dB = sB + (cur ^ 1) * TILE_E + soff;
#pragma unroll 1
  for (int kt = 0; kt + 2 < nk; ++kt) {
    KPTRS(kt)
    int k2 = kt + 2 + kshift; if (k2 >= nk) k2 -= nk; k2 *= 64;
    gemm_kstep<true, true>(cA, cB, nA, nB, dA, dB, Ag + k2, Wg + k2, lda, K, ra, rb, f0, acc);
    if (rowss != nullptr && kt == 3) {
#pragma unroll
      for (int mt = 0; mt < 2; ++mt)
#pragma unroll
        for (int i = 0; i < 16; ++i) {
          const float rs = sRS[wm * 64 + mt * 32 + crow(i, h)];
          acc[mt][0][i] *= rs; acc[mt][1][i] *= rs;
        }
    }
  }
  {
    KPTRS(nk - 2)
    if (has_next) {
      const bfu* Agn = A + (size_t)(nbm * 128 + (tid >> 3)) * lda + (tid & 7) * 8 + k0;
      const bfu* Wgn = W + (size_t)(nbn * 128 + (tid >> 3)) * K + (tid & 7) * 8 + k0;
      gemm_kstep<true, true>(cA, cB, nA, nB, dA, dB, Agn, Wgn, lda, K, ra, rb, f0, acc);
    } else {
      gemm_kstep<true, false>(cA, cB, nA, nB, dA, dB, Ag, Wg, lda, K, ra, rb, f0, acc);
    }
  }
  {
    KPTRS(nk - 1)
    if (resp != nullptr) {
#pragma unroll
      for (int mt = 0; mt < 2; ++mt)
#pragma unroll
        for (int nt = 0; nt < 2; ++nt)
#pragma unroll
          for (int i = 0; i < 16; ++i) res[(mt * 2 + nt) * 16 + i] = (resp + (mt * 32 + (i & 3) + 8 * (i >> 2)) * D + nt * 32)[reslo];
    }
    __builtin_amdgcn_sched_barrier(0);
    gemm_kstep<false, false>(cA, cB, nA, nB, dA, dB, Ag, Wg, lda, K, ra, rb, f0, acc);
  }
#undef KPTRS
  __syncthreads();
}

DI void gemm_mainloop(const bfu* __restrict__ A, int lda, const bfu* __restrict__ W, int K, int bm, int bn, int kshift,
                      const float* rowss, char* lds, f32x16 (&acc)[2][2]) {
  u32x4 ra[4], rb[4]; float res[64];
  gemm_mainloop_x(A, lda, W, K, bm, bn, kshift, rowss, lds, acc, ra, rb, false, false, 0, 0, nullptr, 0u, res);
}

DI int vblock() { const int G = gridDim.x, bx = blockIdx.x; return (G & 7) == 0 ? (bx & 7) * (G >> 3) + (bx >> 3) : bx; }
DI int tile_at(int k, int ntiles) {
  const int G = gridDim.x, nfull = (ntiles / G) * G, base = k * G;
  if (base < nfull) return base + vblock();
  if (base == nfull) { const int t = nfull + (int)blockIdx.x; return t < ntiles ? t : -1; }
  return -1;
}
DI void tile_coords(int id, int NT, int& bm, int& bn) { const int per = 8 * NT; const int sg = id / per, rem = id % per; bm = sg * 8 + (rem & 7); bn = rem >> 3; }

constexpr int SCS = 129;
DI void stage_acc(float* sC, const f32x16 (&acc)[2][2]) {
  const int lane = threadIdx.x & 63, wave = threadIdx.x >> 6, r = lane & 31, h = lane >> 5, wm = wave >> 1, wn = wave & 1;
#pragma unroll
  for (int mt = 0; mt < 2; ++mt)
#pragma unroll
    for (int nt = 0; nt < 2; ++nt)
#pragma unroll
      for (int i = 0; i < 16; ++i) sC[(wm * 64 + mt * 32 + crow(i, h)) * SCS + wn * 64 + nt * 32 + r] = acc[mt][nt][i];
}

DI void phase_gemm_swiglu(const Params& P, const bfu* Wt, int M, bool rev, char* lds) {
  const bfu* A = (const bfu*)(P.ws + OFF_NBUF);
  bfu* act = (bfu*)(P.ws + OFF_ACT);
  const int NT = 44, ntiles = (M / 128) * NT;
  const int lane = threadIdx.x & 63, wave = threadIdx.x >> 6, r = lane & 31, h = lane >> 5, wm = wave >> 1, wn = wave & 1;
  u32x4 ra[4], rb[4]; bool pref = false;
  for (int k_ = 0, t = tile_at(0, ntiles); t >= 0; ++k_, t = tile_at(k_, ntiles)) {
    int bm, bn; tile_coords(rev ? ntiles - 1 - t : t, NT, bm, bn);
    const int tn = tile_at(k_ + 1, ntiles); const bool has_next = tn >= 0;
    int nbm = 0, nbn = 0; if (has_next) tile_coords(rev ? ntiles - 1 - tn : tn, NT, nbm, nbn);
    f32x16 acc[2][2];
    float res[64];
    gemm_mainloop_x(A, D, Wt, D, bm, bn, 0, nullptr, lds, acc, ra, rb, pref, has_next, nbm, nbn, nullptr, 0u, res);
    pref = has_next;
    bfu* actu = act + (size_t)(bm * 128) * FFN + bn * 64;
    const unsigned odd = (unsigned)(r & 1);
    const unsigned lo = (unsigned)((wm * 64 + 4 * h + (int)odd) * FFN + wn * 32 + r - (int)odd);
#pragma unroll
    for (int mt = 0; mt < 2; ++mt)
#pragma unroll
      for (int j = 0; j < 8; ++j) {
        const int i0 = 2 * j, i1 = 2 * j + 1;
        const unsigned b0 = pack2(silu_f(acc[mt][0][i0]) * acc[mt][1][i0], 0.f) & 0xffffu;
        const unsigned b1 = pack2(silu_f(acc[mt][0][i1]) * acc[mt][1][i1], 0.f) & 0xffffu;
        const unsigned send = odd ? b0 : b1;
        const unsigned recv = (unsigned)__builtin_amdgcn_mov_dpp((int)send, 0xB1, 0xF, 0xF, true);
        const unsigned word = odd ? (recv | (b1 << 16)) : (b0 | (recv << 16));
        *(unsigned*)(actu + (mt * 32 + (i0 & 3) + 8 * (i0 >> 2)) * FFN + lo) = word;
      }
  }
}

DI void phase_gemm_resid(const Params& P, int l, const bfu* A, int K, const bfu* Wt, int M, int gidx, float gs,
                         const float* src_lat, const float* src_ctx, int kshift, const float* rowss, bool rev, char* lds) {
  const float* mods = (const float*)(P.ws + moff(l));
  float* dst_lat = P.out; float* dst_ctx = (float*)(P.ws + OFF_HC);
  const int NT = 8, ntiles = (M / 128) * NT;
  const int lane = threadIdx.x & 63, wave = threadIdx.x >> 6, r = lane & 31, h = lane >> 5, wm = wave >> 1, wn = wave & 1;
  u32x4 ra[4], rb[4]; bool pref = false;
  for (int k_ = 0, t = tile_at(0, ntiles); t >= 0; ++k_, t = tile_at(k_, ntiles)) {
    int bm, bn; tile_coords(rev ? ntiles - 1 - t : t, NT, bm, bn);
    const int tn = tile_at(k_ + 1, ntiles); const bool has_next = tn >= 0;
    int nbm = 0, nbn = 0; if (has_next) tile_coords(rev ? ntiles - 1 - tn : tn, NT, nbm, nbn);
    f32x16 acc[2][2];
    const int row0 = bm * 128;
    const bool lat = row0 < TL;
    const size_t uoff = (size_t)(lat ? row0 : row0 - TL) * D + bn * 128;
    const unsigned lo = (unsigned)((wm * 64 + 4 * h) * D + wn * 64 + r);
    const float* resp = (lat ? src_lat : src_ctx) + uoff;
    float res[64];
    gemm_mainloop_x(A, K, Wt, K, bm, bn, kshift, rowss, lds, acc, ra, rb, false, false, nbm, nbn, resp, lo, res);
    const float* gate = mods + row_mrow(row0) * NMOD + gidx * D;
    float* dstp = (lat ? dst_lat : dst_ctx) + uoff;
#pragma unroll
    for (int mt = 0; mt < 2; ++mt)
#pragma unroll
      for (int nt = 0; nt < 2; ++nt) {
        const float gv = gs * gate[bn * 128 + wn * 64 + nt * 32 + r];
#pragma unroll
        for (int i = 0; i < 16; ++i)
          (dstp + (mt * 32 + (i & 3) + 8 * (i >> 2)) * D + nt * 32)[lo] = res[(mt * 2 + nt) * 16 + i] + gv * acc[mt][nt][i];
      }
  }
}

template <int NF>
DI void rope2d(float* v, int t) {
  const float ri = (float)(t >> 6), ci = (float)(t & 63);
#pragma unroll
  for (int d = 0; d < NF; ++d) {
    const float inv = exp2f(-(float)d * (13.287712379549449f / NF));
    float ar = ri * inv, ac = ci * inv;
    float cr = __cosf(ar), sr = __sinf(ar), cc = __cosf(ac), sc = __sinf(ac);
    float x1 = v[d], x2 = v[NF + d];
    v[d] = x1 * cr - x2 * sr; v[NF + d] = x2 * cr + x1 * sr;
    float y1 = v[2 * NF + d], y2 = v[3 * NF + d];
    v[2 * NF + d] = y1 * cc - y2 * sc; v[3 * NF + d] = y2 * cc + y1 * sc;
  }
}

DI void store_row_bf16_64(bfu* dst, const float* v) {
#pragma unroll
  for (int c = 0; c < 8; ++c) {
    u32x4 o; o[0] = pack2(v[c * 8], v[c * 8 + 1]); o[1] = pack2(v[c * 8 + 2], v[c * 8 + 3]); o[2] = pack2(v[c * 8 + 4], v[c * 8 + 5]); o[3] = pack2(v[c * 8 + 6], v[c * 8 + 7]);
    *(u32x4*)(dst + c * 8) = o;
  }
}

DI void write_raw_rows(const float* sC, bfu* dst, int pitch, int col0, int grow0) {
  const int tid = threadIdx.x, rr = tid & 127, half = tid >> 7;
  float v[64];
#pragma unroll
  for (int j = 0; j < 64; ++j) v[j] = sC[rr * SCS + half * 64 + j];
  store_row_bf16_64(dst + (size_t)(grow0 + rr) * pitch + col0 + half * 64, v);
}

DI void write_col_T(const float* sC, int col, int half, bfu* dstT, float sc0, const float* rscale) {
#pragma unroll
  for (int c = 0; c < 8; ++c) {
    float v[8];
#pragma unroll
    for (int j = 0; j < 8; ++j) { const int rr = half * 64 + c * 8 + j; v[j] = sC[rr * SCS + col] * (rscale ? rscale[rr] : sc0); }
    u32x4 o; o[0] = pack2(v[0], v[1]); o[1] = pack2(v[2], v[3]); o[2] = pack2(v[4], v[5]); o[3] = pack2(v[6], v[7]);
    *(u32x4*)(dstT + half * 64 + c * 8) = o;
  }
}

DI void phase_gemm_win(const Params& P, int l, bool rev, char* lds) {
  const bfu* A = (const bfu*)(P.ws + OFF_NBUF);
  const bfu* Wt = (const bfu*)(P.ws + woff(l)) + W_WIN;
  float* sC = (float*)lds;
  const int NT = 21, ntiles = 144 * NT;
  const int tid = threadIdx.x;
  for (int k_ = 0, t = tile_at(0, ntiles); t >= 0; ++k_, t = tile_at(k_, ntiles)) {
    int bm, bn; tile_coords(rev ? ntiles - 1 - t : t, NT, bm, bn);
    f32x16 acc[2][2];
    gemm_mainloop(A, D, Wt, D, bm, bn, 0, nullptr, lds, acc);
    stage_acc(sC, acc);
    __syncthreads();
    const int grow0 = bm * 128;
    const bool lat = grow0 < TL;
    const int b = row_b(grow0), pos0 = row_pos(grow0);
    if (bn < 8) {
      const int mixer = bn >> 2, sub = bn & 3;
      if (sub < 3) {
        const int rr = tid & 127, hh = tid >> 7;
        float v[64];
#pragma unroll
        for (int j = 0; j < 64; ++j) v[j] = sC[rr * SCS + hh * 64 + j];
        if (mixer == 1) {
          float ss = 0.f;
#pragma unroll
          for (int j = 0; j < 64; ++j) ss += v[j] * v[j];
          const float rn = rsqrtf(ss * (1.f / 64.f) + EPS);
          const float* gn = (sub < 2 ? P.in[I_BQN] : P.in[I_BKN]) + l * 64;
#pragma unroll
          for (int j = 0; j < 64; ++j) v[j] = v[j] * rn * gn[j];
        }
        if (lat) rope2d<16>(v, pos0 + rr - CTX);
        bfu* dst;
        if (sub < 2) {
#pragma unroll
          for (int j = 0; j < 64; ++j) v[j] *= 0.125f * 1.4426950408889634f;
          const int hq = sub * 2 + hh;
          dst = (bfu*)(P.ws + (mixer ? OFF_QB : OFF_QA)) + ((size_t)(b * 4 + hq) * SA + pos0 + rr) * 64;
        } else {
          dst = (bfu*)(P.ws + (mixer ? OFF_KB : OFF_KA)) + ((size_t)(b * 2 + hh) * SA + pos0 + rr) * 64;
        }
        store_row_bf16_64(dst, v);
      } else {
        const int col = tid & 127, half = tid >> 7, kvh = col >> 6, d = col & 63;
        bfu* dstT = (bfu*)(P.ws + (mixer ? OFF_VTB : OFF_VTA)) + ((size_t)(b * 2 + kvh) * 64 + d) * SA + pos0;
        write_col_T(sC, col, half, dstT, 1.f, nullptr);
      }
    } else if (bn < 12) {
      if (bn < 10) write_raw_rows(sC, (bfu*)(P.ws + OFF_CQ), 256, (bn - 8) * 128, grow0);
      else if (bn == 10) write_raw_rows(sC, (bfu*)(P.ws + OFF_CKV), 128, 0, grow0);
      else if (tid < 128) {
        const int rr = tid;
        float v[32];
#pragma unroll
        for (int j = 0; j < 32; ++j) v[j] = sC[rr * SCS + j];
        if (lat) rope2d<8>(v, pos0 + rr - CTX);
        u32x4 o[4];
#pragma unroll
        for (int c = 0; c < 4; ++c) { o[c][0] = pack2(v[c * 8], v[c * 8 + 1]); o[c][1] = pack2(v[c * 8 + 2], v[c * 8 + 3]); o[c][2] = pack2(v[c * 8 + 4], v[c * 8 + 5]); o[c][3] = pack2(v[c * 8 + 6], v[c * 8 + 7]); }
#pragma unroll
        for (int hd = 0; hd < 4; ++hd) {
          bfu* dst = (bfu*)(P.ws + OFF_KC) + ((size_t)(b * 4 + hd) * SA + pos0 + rr) * 96 + 64;
#pragma unroll
          for (int c = 0; c < 4; ++c) *(u32x4*)(dst + c * 8) = o[c];
        }
      }
    } else {
      if (bn < 14) write_raw_rows(sC, (bfu*)(P.ws + OFF_Z), 256, (bn - 12) * 128, grow0);
      else if (bn < 20) write_raw_rows(sC, (bfu*)(P.ws + OFF_XBC), 768, (bn - 14) * 128, grow0);
      else if (tid < 8) {
        const int j = tid;
        const float bias = P.in[I_DTB][l * 8 + j];
        const float a_neg = -__expf(P.in[I_ALOG][l * 8 + j]);
        float* DT = (float*)(P.ws + OFF_DT); float* CS = (float*)(P.ws + OFF_CS);
        float run = 0.f;
        for (int rr = 0; rr < 128; ++rr) {
          const float x = sC[rr * SCS + j] + bias;
          const float dt = fmaxf(x, 0.f) + log1pf(__expf(-fabsf(x)));
          run += dt * a_neg;
          DT[(size_t)(grow0 + rr) * 8 + j] = dt; CS[(size_t)(grow0 + rr) * 8 + j] = run;
        }
      }
    }
    __syncthreads();
  }
}

DI void mla_uq_tile(const Params& P, int l, int bm, int hd, char* lds) {
  const bfu* A = (const bfu*)(P.ws + OFF_CQ);
  const bfu* Wt = (const bfu*)(P.ws + woff(l)) + W_UQ;
  float* sC = (float*)lds; float* sR = sC + 128 * SCS;
  int tid = threadIdx.x; asm volatile("" : "+v"(tid));
  f32x16 acc[2][2];
  gemm_mainloop(A, 256, Wt, 256, bm, hd, 0, nullptr, lds, acc);
  stage_acc(sC, acc);
  const int grow0 = bm * 128;
  {
    const int rr = tid >> 1, part = tid & 1;
    const u32x4* src = (const u32x4*)(A + (size_t)(grow0 + rr) * 256 + part * 128);
    float ss = 0.f;
#pragma unroll
    for (int c = 0; c < 16; ++c) { u32x4 u = src[c];
#pragma unroll
      for (int j = 0; j < 4; ++j) { float a = bflo(u[j]), bb = bfhi(u[j]); ss += a * a + bb * bb; } }
    ss += __shfl_xor(ss, 1);
    if (part == 0) sR[rr] = rsqrtf(ss * (1.f / 256.f) + EPS);
  }
  __syncthreads();
  if (tid < 128) {
    const int rr = tid;
    const bool lat = grow0 < TL;
    const int b = row_b(grow0), pos = row_pos(grow0) + rr;
    const float rs = sR[rr];
    const float qs = rs * (0.10206207261596575f * 1.4426950408889634f);
    bfu* dst = (bfu*)(P.ws + OFF_QC) + ((size_t)(b * 4 + hd) * SA + pos) * 96;
    float v[64];
#pragma unroll
    for (int j = 0; j < 64; ++j) v[j] = sC[rr * SCS + j] * qs;
    store_row_bf16_64(dst, v);
    float w[32];
#pragma unroll
    for (int j = 0; j < 32; ++j) w[j] = sC[rr * SCS + 64 + j] * qs;
    if (lat) rope2d<8>(w, pos - CTX);
#pragma unroll
    for (int c = 0; c < 4; ++c) {
      u32x4 o; o[0] = pack2(w[c * 8], w[c * 8 + 1]); o[1] = pack2(w[c * 8 + 2], w[c * 8 + 3]); o[2] = pack2(w[c * 8 + 4], w[c * 8 + 5]); o[3] = pack2(w[c * 8 + 6], w[c * 8 + 7]);
      *(u32x4*)(dst + 64 + c * 8) = o;
    }
  }
  __syncthreads();
}

DI void mla_ukv_tile(const Params& P, int l, int bm, int hd, char* lds) {
  const bfu* A = (const bfu*)(P.ws + OFF_CKV);
  const bfu* Wt = (const bfu*)(P.ws + woff(l)) + W_UKV;
  float* sC = (float*)lds; float* sR = sC + 128 * SCS;
  int tid = threadIdx.x; asm volatile("" : "+v"(tid));
  f32x16 acc[2][2];
  gemm_mainloop(A, 128, Wt, 128, bm, hd, 0, nullptr, lds, acc);
  stage_acc(sC, acc);
  const int grow0 = bm * 128;
  {
    const int rr = tid >> 1, part = tid & 1;
    const u32x4* src = (const u32x4*)(A + (size_t)(grow0 + rr) * 128 + part * 64);
    float ss = 0.f;
#pragma unroll
    for (int c = 0; c < 8; ++c) { u32x4 u = src[c];
#pragma unroll
      for (int j = 0; j < 4; ++j) { float a = bflo(u[j]), bb = bfhi(u[j]); ss += a * a + bb * bb; } }
    ss += __shfl_xor(ss, 1);
    if (part == 0) sR[rr] = rsqrtf(ss * (1.f / 128.f) + EPS);
  }
  __syncthreads();
  const int b = row_b(grow0), pos0 = row_pos(grow0);
  if (tid < 128) {
    const int rr = tid;
    const float rs = sR[rr];
    float v[64];
#pragma unroll
    for (int j = 0; j < 64; ++j) v[j] = sC[rr * SCS + j] * rs;
    store_row_bf16_64((bfu*)(P.ws + OFF_KC) + ((size_t)(b * 4 + hd) * SA + pos0 + rr) * 96, v);
  } else {
    const int q = tid - 128, d = q & 63, half = q >> 6;
    bfu* dstT = (bfu*)(P.ws + OFF_VTC) + ((size_t)(b * 4 + hd) * 64 + d) * SA + pos0;
    write_col_T(sC, 64 + d, half, dstT, 1.f, sR);
  }
  __syncthreads();
}

DI void conv_prep_tile(const Params& P, int l, int rt, int ct, char* lds) {
  float* sIn = (float*)lds;
  int tid = threadIdx.x; asm volatile("" : "+v"(tid));
  const int grow0 = rt * 128;
  const bool lat = grow0 < TL;
  const int b = row_b(grow0), pos0 = row_pos(grow0);
  const int seg_lo = lat ? b * SEQ : TL + b * CTX, seg_hi = seg_lo + (lat ? SEQ : CTX);
  const bfu* X = (const bfu*)(P.ws + OFF_XBC);
  for (int idx = tid; idx < 132 * 16; idx += 256) {
    const int rr = idx >> 4, c8 = idx & 15;
    const int grow = grow0 - 2 + rr;
    u32x4 u = {0u, 0u, 0u, 0u};
    if (grow >= seg_lo && grow < seg_hi) u = *(const u32x4*)(X + (size_t)grow * 768 + ct * 128 + c8 * 8);
    float* d = sIn + rr * 128 + c8 * 8;
#pragma unroll
    for (int j = 0; j < 4; ++j) { d[2 * j] = bflo(u[j]); d[2 * j + 1] = bfhi(u[j]); }
  }
  __syncthreads();
  const int cc = tid & 127, half = tid >> 7, ch = ct * 128 + cc;
  float w[5];
#pragma unroll
  for (int k = 0; k < 5; ++k) w[k] = P.in[I_CONVW][(size_t)l * 5 * 768 + k * 768 + ch];
  const float bias = P.in[I_CONVB][l * 768 + ch];
  bfu* dT = nullptr; bfu* dR = nullptr;
  if (ct < 2) { const int hd = ct * 2 + (cc >> 6), p = cc & 63; dT = (bfu*)(P.ws + OFF_XT) + ((size_t)(b * 4 + hd) * 64 + p) * SA + pos0 + half * 64; }
  else if (ct < 4) { const int g = ct - 2; dT = (bfu*)(P.ws + OFF_BT) + ((size_t)(b * 2 + g) * 128 + cc) * SA + pos0 + half * 64;
                     dR = (bfu*)(P.ws + OFF_BM) + ((size_t)(b * 2 + g) * SA + pos0 + half * 64) * 128 + cc; }
  else { const int g = ct - 4; dR = (bfu*)(P.ws + OFF_CM) + ((size_t)(b * 2 + g) * SA + pos0 + half * 64) * 128 + cc; }
  for (int c = 0; c < 8; ++c) {
    float in[12];
#pragma unroll
    for (int j = 0; j < 12; ++j) in[j] = sIn[(half * 64 + c * 8 + j) * 128 + cc];
    float o[8];
#pragma unroll
    for (int j = 0; j < 8; ++j) {
      float s = bias;
#pragma unroll
      for (int k = 0; k < 5; ++k) s += w[k] * in[j + k];
      o[j] = silu_f(s);
    }
    if (dT) { u32x4 q; q[0] = pack2(o[0], o[1]); q[1] = pack2(o[2], o[3]); q[2] = pack2(o[4], o[5]); q[3] = pack2(o[6], o[7]); *(u32x4*)(dT + c * 8) = q; }
    if (dR) {
#pragma unroll
      for (int j = 0; j < 8; ++j) dR[(size_t)(c * 8 + j) * 128] = f2bf(o[j]);
    }
  }
  __syncthreads();
}

DI void phase_mla_conv(const Params& P, int l, char* lds) {
  const int n_uq = 144 * 4, n_ukv = 144 * 4, n_cv = 144 * 6;
  const int total = n_uq + n_ukv + n_cv;
  for (int k_ = 0, it = tile_at(0, total); it >= 0; ++k_, it = tile_at(k_, total)) {
    if (it < n_uq) mla_uq_tile(P, l, it >> 2, it & 3, lds);
    else if (it < n_uq + n_ukv) { const int id = it - n_uq; mla_ukv_tile(P, l, id >> 2, id & 3, lds); }
    else { const int id = it - n_uq - n_ukv; conv_prep_tile(P, l, id / 6, id % 6, lds); }
  }
}

template <int DQK, bool NOMAX = false>
DI void attn_item(const bfu* __restrict__ Qp, const bfu* __restrict__ Kp, const bfu* __restrict__ VTp, int n1, int p1, int n2, int p2,
                  bool masked, int q0lat, bool has_sink, float sink, bfu* __restrict__ Op, char* lds) {
  constexpr int KS = DQK + 8, NKS = DQK / 16, VS = 72;
  bfu* sK = (bfu*)lds;
  bfu* sV = sK + 64 * KS;
  int tid = threadIdx.x; asm volatile("" : "+v"(tid));
  const int lane = tid & 63, wave = tid >> 6, r = lane & 31, h = lane >> 5;
  bf16x8 qf[NKS];
  const bfu* qrow = Qp + (size_t)(wave * 32 + r) * DQK;
#pragma unroll
  for (int s = 0; s < NKS; ++s) qf[s] = *(const bf16x8*)(qrow + s * 16 + h * 8);
  f32x16 o[2];
#pragma unroll
  for (int i = 0; i < 16; ++i) { o[0][i] = 0.f; o[1][i] = 0.f; }
  float m = has_sink ? sink * 1.4426950408889634f : -INFINITY;
  float lsum = (has_sink && h == 0) ? 1.f : 0.f;
  const int qpos = q0lat + wave * 32 + r;
  const int nt = n1 + n2;
  constexpr int NKC = (64 * (DQK / 8)) / 256;
  u32x4 kreg[NKC], vreg[2];
  {
    const int pos = n1 > 0 ? p1 : p2;
#pragma unroll
    for (int i = 0; i < NKC; ++i) { const int c = tid + 256 * i, kr = c / (DQK / 8), kc = c % (DQK / 8); kreg[i] = *(const u32x4*)(Kp + (size_t)(pos + kr) * DQK + kc * 8); }
#pragma unroll
    for (int i = 0; i < 2; ++i) { const int c = tid + 256 * i, d = c >> 3, kc = c & 7; vreg[i] = *(const u32x4*)(VTp + (size_t)d * SA + pos + kc * 8); }
  }
  for (int tt = 0; tt < nt; ++tt) {
    const int pos = tt < n1 ? p1 + tt * 64 : p2 + (tt - n1) * 64;
    __syncthreads();
#pragma unroll
    for (int i = 0; i < NKC; ++i) { const int c = tid + 256 * i, kr = c / (DQK / 8), kc = c % (DQK / 8); *(u32x4*)(sK + kr * KS + kc * 8) = kreg[i]; }
#pragma unroll
    for (int i = 0; i < 2; ++i) { const int c = tid + 256 * i, d = c >> 3, kc = c & 7; *(u32x4*)(sV + d * VS + kc * 8) = vreg[i]; }
    __syncthreads();
    if (tt + 1 < nt) {
      const int pn = (tt + 1) < n1 ? p1 + (tt + 1) * 64 : p2 + (tt + 1 - n1) * 64;
#pragma unroll
      for (int i = 0; i < NKC; ++i) { const int c = tid + 256 * i, kr = c / (DQK / 8), kc = c % (DQK / 8); kreg[i] = *(const u32x4*)(Kp + (size_t)(pn + kr) * DQK + kc * 8); }
#pragma unroll
      for (int i = 0; i < 2; ++i) { const int c = tid + 256 * i, d = c >> 3, kc = c & 7; vreg[i] = *(const u32x4*)(VTp + (size_t)d * SA + pn + kc * 8); }
    }
    __builtin_amdgcn_sched_barrier(0);
    f32x16 s[2];
#pragma unroll
    for (int i = 0; i < 16; ++i) { s[0][i] = 0.f; s[1][i] = 0.f; }
#pragma unroll
    for (int mt = 0; mt < 2; ++mt)
#pragma unroll
      for (int ks = 0; ks < NKS; ++ks) {
        bf16x8 a = *(const bf16x8*)(sK + (mt * 32 + r) * KS + ks * 16 + h * 8);
        s[mt] = MFMA(a, qf[ks], s[mt]);
      }
    if (masked && tt >= n1) {
      const int kbase = pos - CTX;
#pragma unroll
      for (int mt = 0; mt < 2; ++mt)
#pragma unroll
        for (int i = 0; i < 16; ++i) {
          const int kp = kbase + mt * 32 + crow(i, h);
          const int dlt = qpos - kp;
          if (dlt > 128 || dlt < -128) s[mt][i] = -INFINITY;
        }
    }
    if (NOMAX) {
      float rs = 0.f;
#pragma unroll
      for (int mt = 0; mt < 2; ++mt)
#pragma unroll
        for (int i = 0; i < 16; ++i) { const float p = __builtin_amdgcn_exp2f(s[mt][i]); s[mt][i] = p; rs += p; }
      lsum += rs;
    } else {
    float mx = s[0][0];
#pragma unroll
    for (int i = 1; i < 16; ++i) mx = fmaxf(mx, s[0][i]);
#pragma unroll
    for (int i = 0; i < 16; ++i) mx = fmaxf(mx, s[1][i]);
    mx = fmaxf(mx, __shfl_xor(mx, 32));
    const float mn = fmaxf(m, mx);
    const float alpha = __builtin_amdgcn_exp2f(m - mn);
    float rs = 0.f;
#pragma unroll
    for (int mt = 0; mt < 2; ++mt)
#pragma unroll
      for (int i = 0; i < 16; ++i) { const float p = __builtin_amdgcn_exp2f(s[mt][i] - mn); s[mt][i] = p; rs += p; }
    lsum = lsum * alpha + rs;
    if (__ballot(mn != m) != 0ull) {
#pragma unroll
      for (int i = 0; i < 16; ++i) { o[0][i] *= alpha; o[1][i] *= alpha; }
    }
    m = mn;
    }
#pragma unroll
    for (int s2 = 0; s2 < 4; ++s2) {
      const int mt = s2 >> 1, ss = s2 & 1;
      u32x4 pb;
#pragma unroll
      for (int j = 0; j < 4; ++j) pb[j] = pack2(s[mt][8 * ss + 2 * j], s[mt][8 * ss + 2 * j + 1]);
      const bf16x8 bfrag = __builtin_bit_cast(bf16x8, pb);
#pragma unroll
      for (int mt2 = 0; mt2 < 2; ++mt2) {
        const bfu* vp = sV + (mt2 * 32 + r) * VS + 32 * mt + 16 * ss + 4 * h;
        bf16x4 lo = *(const bf16x4*)vp, hi = *(const bf16x4*)(vp + 8);
        const bf16x8 a = __builtin_shufflevector(lo, hi, 0, 1, 2, 3, 4, 5, 6, 7);
        o[mt2] = MFMA(a, bfrag, o[mt2]);
      }
    }
  }
  const float ltot = lsum + __shfl_xor(lsum, 32);
  const float inv = 1.f / ltot;
  bfu* orow = Op + (size_t)(wave * 32 + r) * D;
#pragma unroll
  for (int mt2 = 0; mt2 < 2; ++mt2)
#pragma unroll
    for (int g = 0; g < 4; ++g) {
      u32x2 q; q[0] = pack2(o[mt2][4 * g] * inv, o[mt2][4 * g + 1] * inv); q[1] = pack2(o[mt2][4 * g + 2] * inv, o[mt2][4 * g + 3] * inv);
      *(u32x2*)(orow + mt2 * 32 + 8 * g + 4 * h) = q;
    }
}

DI int chunk_row0(int b, int oc) { return oc < 2 ? TL + b * CTX + oc * 128 : b * SEQ + (oc - 2) * 128; }

DI void ssd_state_item(const Params& P, int l, int id, char* lds) {
  const int hd = id & 3, oc = (id >> 2) % NCH, dir = (id / (4 * NCH)) & 1, b = id / (8 * NCH);
  int tid = threadIdx.x; asm volatile("" : "+v"(tid));
  const int lane = tid & 63, wave = tid >> 6, r = lane & 31, h = lane >> 5;
  bfu* sX = (bfu*)lds;
  float* sW = (float*)(lds + 64 * 136 * 2);
  const int grow0 = chunk_row0(b, oc), pos0 = oc * 128, g = hd >> 1, col = dir * 4 + hd;
  const float* DT = (const float*)(P.ws + OFF_DT); const float* CS = (const float*)(P.ws + OFF_CS);
  const bfu* XT = (const bfu*)(P.ws + OFF_XT) + ((size_t)(b * 4 + hd) * 64) * SA + pos0;
  const bfu* BT = (const bfu*)(P.ws + OFF_BT) + ((size_t)(b * 2 + g) * 128 + wave * 32 + r) * SA + pos0 + h * 8;
  u32x4 xu[4];
#pragma unroll
  for (int i = 0; i < 4; ++i) { const int c = tid + 256 * i, p = c >> 4, j8 = (c & 15) * 8; xu[i] = *(const u32x4*)(XT + (size_t)p * SA + j8); }
  bf16x8 bbv[8];
#pragma unroll
  for (int s = 0; s < 8; ++s) bbv[s] = *(const bf16x8*)(BT + s * 16);
  __builtin_amdgcn_sched_barrier(0);
  __syncthreads();
  if (tid < 128) {
    const float cs = CS[(size_t)(grow0 + tid) * 8 + col], dt = DT[(size_t)(grow0 + tid) * 8 + col];
    const float tot = CS[(size_t)(grow0 + 127) * 8 + col];
    const float a_neg = -__expf(P.in[I_ALOG][l * 8 + col]);
    sW[tid] = dir == 0 ? dt * __expf(tot - cs) : dt * __expf(cs - dt * a_neg);
  }
  __syncthreads();
#pragma unroll
  for (int i = 0; i < 4; ++i) {
    const int c = tid + 256 * i, p = c >> 4, j8 = (c & 15) * 8;
    const u32x4 u = xu[i];
    u32x4 q;
#pragma unroll
    for (int j = 0; j < 4; ++j) q[j] = pack2(bflo(u[j]) * sW[j8 + 2 * j], bfhi(u[j]) * sW[j8 + 2 * j + 1]);
    *(u32x4*)(sX + p * 136 + j8) = q;
  }
  __syncthreads();
  f32x16 acc[2];
#pragma unroll
  for (int i = 0; i < 16; ++i) { acc[0][i] = 0.f; acc[1][i] = 0.f; }
#pragma unroll
  for (int s = 0; s < 8; ++s) {
#pragma unroll
    for (int mt = 0; mt < 2; ++mt) {
      const bf16x8 a = *(const bf16x8*)(sX + (mt * 32 + r) * 136 + s * 16 + h * 8);
      acc[mt] = MFMA(a, bbv[s], acc[mt]);
    }
  }
  bfu* ST = (bfu*)(P.ws + OFF_ST) + ((size_t)((b * 2 + dir) * NCH + oc) * 4 + hd) * 8192;
#pragma unroll
  for (int mt = 0; mt < 2; ++mt)
#pragma unroll
    for (int i = 0; i < 16; ++i) ST[(mt * 32 + crow(i, h)) * 128 + wave * 32 + r] = f2bf(acc[mt][i]);
}

DI void phase_scan(const Params& P) {
  const float* CS = (const float*)(P.ws + OFF_CS);
  const int total = NB * 2 * 4 * 1024;
  for (int u = blockIdx.x * 256 + threadIdx.x; u < total; u += gridDim.x * 256) {
    const int e8 = u & 1023, hd = (u >> 10) & 3, dir = (u >> 12) & 1, b = u >> 13;
    bfu* base = (bfu*)(P.ws + OFF_ST) + ((size_t)(b * 2 + dir) * NCH * 4 + hd) * 8192 + e8 * 8;
    u32x4 st[NCH]; float dec[NCH];
#pragma unroll
    for (int step = 0; step < NCH; ++step) {
      const int oc = dir == 0 ? step : (step < 2 ? 1 - step : 19 - step);
      st[step] = *(const u32x4*)(base + (size_t)oc * 4 * 8192);
      dec[step] = CS[(size_t)(chunk_row0(b, oc) + 127) * 8 + dir * 4 + hd];
    }
    __builtin_amdgcn_sched_barrier(0);
    float hs[8];
#pragma unroll
    for (int j = 0; j < 8; ++j) hs[j] = 0.f;
#pragma unroll
    for (int step = 0; step < NCH; ++step) {
      const int oc = dir == 0 ? step : (step < 2 ? 1 - step : 19 - step);
      u32x4 o;
#pragma unroll
      for (int j = 0; j < 4; ++j) o[j] = pack2(hs[2 * j], hs[2 * j + 1]);
      *(u32x4*)(base + (size_t)oc * 4 * 8192) = o;
      const float d = __expf(dec[step]);
#pragma unroll
      for (int j = 0; j < 4; ++j) { hs[2 * j] = d * hs[2 * j] + bflo(st[step][j]); hs[2 * j + 1] = d * hs[2 * j + 1] + bfhi(st[step][j]); }
    }
  }
}

DI void ssd_y_item(const Params& P, int l, int b, int oc, int hd, char* lds) {
  int tid = threadIdx.x; asm volatile("" : "+v"(tid));
  const int lane = tid & 63, wave = tid >> 6, r = lane & 31, h = lane >> 5;
  bfu* sB = (bfu*)lds;
  bfu* sX = sB + 128 * 136;
  float* sF = (float*)(sX + 64 * 136);
  const int grow0 = chunk_row0(b, oc), pos0 = oc * 128, g = hd >> 1;
  const float* DT = (const float*)(P.ws + OFF_DT); const float* CS = (const float*)(P.ws + OFF_CS);
  const float anb = -__expf(P.in[I_ALOG][l * 8 + 4 + hd]);
  __syncthreads();
  if (tid < 128) {
    const size_t o = (size_t)(grow0 + tid) * 8;
    const float csf = CS[o + hd], dtf = DT[o + hd], csb = CS[o + 4 + hd], dtb = DT[o + 4 + hd];
    sF[tid] = csf; sF[128 + tid] = csb - dtb * anb; sF[256 + tid] = dtf; sF[384 + tid] = dtb;
  }
  const float totb = CS[(size_t)(grow0 + 127) * 8 + 4 + hd];
  {
    const bfu* BMp = (const bfu*)(P.ws + OFF_BM) + ((size_t)(b * 2 + g) * SA + pos0) * 128;
#pragma unroll
    for (int i = 0; i < 8; ++i) { const int c = tid + 256 * i, j = c >> 4, n8 = (c & 15) * 8; *(u32x4*)(sB + j * 136 + n8) = *(const u32x4*)(BMp + (size_t)j * 128 + n8); }
    const bfu* XT = (const bfu*)(P.ws + OFF_XT) + ((size_t)(b * 4 + hd) * 64) * SA + pos0;
#pragma unroll
    for (int i = 0; i < 4; ++i) { const int c = tid + 256 * i, p = c >> 4, j8 = (c & 15) * 8; *(u32x4*)(sX + p * 136 + j8) = *(const u32x4*)(XT + (size_t)p * SA + j8); }
  }
  __syncthreads();
  const int qi = wave * 32 + r;
  bf16x8 cf[8];
  {
    const bfu* CMp = (const bfu*)(P.ws + OFF_CM) + ((size_t)(b * 2 + g) * SA + pos0 + qi) * 128 + h * 8;
#pragma unroll
    for (int s = 0; s < 8; ++s) cf[s] = *(const bf16x8*)(CMp + s * 16);
  }
  f32x16 g4[4];
#pragma unroll
  for (int mt = 0; mt < 4; ++mt) {
#pragma unroll
    for (int i = 0; i < 16; ++i) g4[mt][i] = 0.f;
#pragma unroll
    for (int s = 0; s < 8; ++s) {
      const bf16x8 a = *(const bf16x8*)(sB + (mt * 32 + r) * 136 + s * 16 + h * 8);
      g4[mt] = MFMA(a, cf[s], g4[mt]);
    }
  }
  const float my_csf = sF[qi], my_eb = sF[128 + qi];
#pragma unroll
  for (int mt = 0; mt < 4; ++mt)
#pragma unroll
    for (int i = 0; i < 16; ++i) {
      const int j = mt * 32 + crow(i, h);
      float f = 0.f;
      if (j <= qi) f += __expf(my_csf - sF[j]) * sF[256 + j];
      if (j >= qi) f += __expf(sF[128 + j] - my_eb) * sF[384 + j];
      g4[mt][i] *= f;
    }
  f32x16 y[2];
#pragma unroll
  for (int i = 0; i < 16; ++i) { y[0][i] = 0.f; y[1][i] = 0.f; }
#pragma unroll
  for (int s2 = 0; s2 < 8; ++s2) {
    const int mt = s2 >> 1, ss = s2 & 1;
    u32x4 pb;
#pragma unroll
    for (int j = 0; j < 4; ++j) pb[j] = pack2(g4[mt][8 * ss + 2 * j], g4[mt][8 * ss + 2 * j + 1]);
    const bf16x8 bfrag = __builtin_bit_cast(bf16x8, pb);
#pragma unroll
    for (int mt2 = 0; mt2 < 2; ++mt2) {
      const bfu* vp = sX + (mt2 * 32 + r) * 136 + 32 * mt + 16 * ss + 4 * h;
      bf16x4 lo = *(const bf16x4*)vp, hi = *(const bf16x4*)(vp + 8);
      const bf16x8 a = __builtin_shufflevector(lo, hi, 0, 1, 2, 3, 4, 5, 6, 7);
      y[mt2] = MFMA(a, bfrag, y[mt2]);
    }
  }
#pragma unroll
  for (int dir = 0; dir < 2; ++dir) {
    f32x16 tmp[2];
#pragma unroll
    for (int i = 0; i < 16; ++i) { tmp[0][i] = 0.f; tmp[1][i] = 0.f; }
    const bfu* hin = (const bfu*)(P.ws + OFF_ST) + ((size_t)((b * 2 + dir) * NCH + oc) * 4 + hd) * 8192 + h * 8;
#pragma unroll
    for (int mt2 = 0; mt2 < 2; ++mt2) {
      bf16x8 hv[8];
#pragma unroll
      for (int s = 0; s < 8; ++s) hv[s] = *(const bf16x8*)(hin + (mt2 * 32 + r) * 128 + s * 16);
      __builtin_amdgcn_sched_barrier(0);
#pragma unroll
      for (int s = 0; s < 8; ++s) tmp[mt2] = MFMA(hv[s], cf[s], tmp[mt2]);
    }
    const float sc = dir == 0 ? __expf(my_csf) : __expf(totb - my_eb);
#pragma unroll
    for (int i = 0; i < 16; ++i) { y[0][i] += sc * tmp[0][i]; y[1][i] += sc * tmp[1][i]; }
  }
  const float skip = P.in[I_SKIP][l * 4 + hd];
  const int grow = grow0 + qi;
  const bfu* Zr = (const bfu*)(P.ws + OFF_Z) + (size_t)grow * 256 + hd * 64;
  bfu* Or = (bfu*)(P.ws + OFF_NBUF) + (size_t)grow * D + 768 + hd * 64;
  float ss = 0.f;
#pragma unroll
  for (int mt2 = 0; mt2 < 2; ++mt2)
#pragma unroll
    for (int gq = 0; gq < 4; ++gq) {
      const int p0 = mt2 * 32 + 8 * gq + 4 * h;
      const u32x2 zz = *(const u32x2*)(Zr + p0);
      float u4[4];
#pragma unroll
      for (int j = 0; j < 4; ++j) {
        const float x = bf2f(sX[(p0 + j) * 136 + qi]);
        const float z = (j & 1) ? bfhi(zz[j >> 1]) : bflo(zz[j >> 1]);
        const float u = (y[mt2][4 * gq + j] + skip * x) * silu_f(z);
        u4[j] = u; ss += u * u;
      }
      u32x2 q; q[0] = pack2(u4[0], u4[1]); q[1] = pack2(u4[2], u4[3]);
      *(u32x2*)(Or + p0) = q;
    }
  ss += __shfl_xor(ss, 32);
  if (h == 0) ((float*)(P.ws + OFF_ROWSS))[(size_t)grow * 4 + hd] = ss;
}

DI void phase_ssd_y(const Params& P, int l, char* lds) {
  const int oc_lo = l == 0 ? 0 : 2, noc = NCH - oc_lo;
  const int total = NB * noc * 4;
  for (int it = blockIdx.x; it < total; it += gridDim.x) {
    const int hd = it & 3, oc = oc_lo + (it >> 2) % noc, b = (it >> 2) / noc;
    ssd_y_item(P, l, b, oc, hd, lds);
  }
}

template <int MODE>
DI void phase_attn(const Params& P, int l, char* lds) {
  const int nB = MODE == 1 ? 512 : 0, nC = MODE == 0 ? 512 : 0, nA = MODE == 2 ? 512 : 0;
  const int nS = MODE == 0 ? NB * 2 * NCH * 4 : 0, nX = (MODE == 0 && l == 0) ? 192 : 0;
  const int total = nB + nC + nA + nS + nX;
  bfu* O = (bfu*)(P.ws + OFF_NBUF);
  bool nomaxB = false;
  if (MODE == 1) {
    float gq = fabsf(P.in[I_BQN][l * 64 + (threadIdx.x & 63)]), gk = fabsf(P.in[I_BKN][l * 64 + (threadIdx.x & 63)]);
#pragma unroll
    for (int o_ = 32; o_ >= 1; o_ >>= 1) { gq = fmaxf(gq, __shfl_xor(gq, o_)); gk = fmaxf(gk, __shfl_xor(gk, o_)); }
    nomaxB = gq * gk * 11.6f < 100.f;
  }
  for (int k_ = 0, it = tile_at(0, total); it >= 0; ++k_, it = tile_at(k_, total)) {
    if (it < nB + nC + nA) {
      const int mixer = it < nB ? 1 : (it < nB + nC ? 2 : 0);
      const int id = it < nB ? it : (it < nB + nC ? it - nB : it - nB - nC);
      const int b = id >> 6, hq = (id >> 4) & 3, qb = id & 15;
      const int q0 = qb * 128;
      bfu* Op = O + (size_t)(b * SEQ + q0) * D + (mixer == 0 ? 0 : (mixer == 1 ? 256 : 512)) + hq * 64;
      if (mixer == 1) {
        const bfu* Qp = (const bfu*)(P.ws + OFF_QB) + ((size_t)(b * 4 + hq) * SA + CTX + q0) * 64;
        const bfu* Kp = (const bfu*)(P.ws + OFF_KB) + (size_t)(b * 2 + (hq >> 1)) * SA * 64;
        const bfu* Vp = (const bfu*)(P.ws + OFF_VTB) + (size_t)(b * 2 + (hq >> 1)) * 64 * SA;
        if (nomaxB) attn_item<64, true>(Qp, Kp, Vp, 36, 0, 0, 0, false, 0, false, 0.f, Op, lds);
        else attn_item<64>(Qp, Kp, Vp, 36, 0, 0, 0, false, 0, false, 0.f, Op, lds);
      } else if (mixer == 2) {
        const bfu* Qp = (const bfu*)(P.ws + OFF_QC) + ((size_t)(b * 4 + hq) * SA + CTX + q0) * 96;
        const bfu* Kp = (const bfu*)(P.ws + OFF_KC) + (size_t)(b * 4 + hq) * SA * 96;
        const bfu* Vp = (const bfu*)(P.ws + OFF_VTC) + (size_t)(b * 4 + hq) * 64 * SA;
        attn_item<96>(Qp, Kp, Vp, 36, 0, 0, 0, false, 0, false, 0.f, Op, lds);
      } else {
        const bfu* Qp = (const bfu*)(P.ws + OFF_QA) + ((size_t)(b * 4 + hq) * SA + CTX + q0) * 64;
        const bfu* Kp = (const bfu*)(P.ws + OFF_KA) + (size_t)(b * 2 + (hq >> 1)) * SA * 64;
        const bfu* Vp = (const bfu*)(P.ws + OFF_VTA) + (size_t)(b * 2 + (hq >> 1)) * 64 * SA;
        const int lo = q0 - 128 < 0 ? 0 : q0 - 128, hi = q0 + 256 > SEQ ? SEQ : q0 + 256;
        attn_item<64>(Qp, Kp, Vp, 4, 0, (hi - lo) >> 6, CTX + lo, true, q0, true, P.in[I_SINK][l * 4 + hq], Op, lds);
      }
    } else if (it < nB + nC + nA + nS) {
      ssd_state_item(P, l, it - (nB + nC + nA), lds);
    } else {
      const int id = it - (nB + nC + nA + nS);
      const int mixer = id >> 6, b = (id >> 3) & 7, hq = (id >> 1) & 3, qb = id & 1;
      const int q0 = qb * 128;
      bfu* Op = O + (size_t)(TL + b * CTX + q0) * D + mixer * 256 + hq * 64;
      if (mixer == 2) {
        const bfu* Qp = (const bfu*)(P.ws + OFF_QC) + ((size_t)(b * 4 + hq) * SA + q0) * 96;
        const bfu* Kp = (const bfu*)(P.ws + OFF_KC) + (size_t)(b * 4 + hq) * SA * 96;
        const bfu* Vp = (const bfu*)(P.ws + OFF_VTC) + (size_t)(b * 4 + hq) * 64 * SA;
        attn_item<96>(Qp, Kp, Vp, 4, 0, 0, 0, false, 0, false, 0.f, Op, lds);
      } else {
        const bfu* Qp = (const bfu*)(P.ws + (mixer ? OFF_QB : OFF_QA)) + ((size_t)(b * 4 + hq) * SA + q0) * 64;
        const bfu* Kp = (const bfu*)(P.ws + (mixer ? OFF_KB : OFF_KA)) + (size_t)(b * 2 + (hq >> 1)) * SA * 64;
        const bfu* Vp = (const bfu*)(P.ws + (mixer ? OFF_VTB : OFF_VTA)) + (size_t)(b * 2 + (hq >> 1)) * 64 * SA;
        attn_item<64>(Qp, Kp, Vp, 4, 0, 0, 0, false, 0, mixer == 0, mixer == 0 ? P.in[I_SINK][l * 4 + hq] : 0.f, Op, lds);
      }
    }
  }
}


#define XB_TMO      128
#define XB_XCNT(j)  (256  + 64 * (j))
#define XB_XSUB(j)  (1280 + 64 * (j))
#define XB_XGEN(j)  (2304 + 64 * (j))
#define XB_TOP      3328
#define XB_TOPGEN   3392
#define XCD_BAR_WORDS 3456
#define XB_SPIN_CAP (1u << 18)
#define LAS __attribute__((address_space(3)))
DI unsigned xb_ld(unsigned* p)              { return __hip_atomic_load(p, __ATOMIC_RELAXED, __HIP_MEMORY_SCOPE_AGENT); }
DI unsigned xb_add(unsigned* p, unsigned v) { return __hip_atomic_fetch_add(p, v, __ATOMIC_RELAXED, __HIP_MEMORY_SCOPE_AGENT); }
DI unsigned xb_xcc_id() { return (unsigned)__builtin_amdgcn_s_getreg((3 << 11) | 20) & 0xFu; }
#define XB_SPIN(cond, bar) do { unsigned _sp = 0; while (cond) { __builtin_amdgcn_s_sleep(1); \
    if ((++_sp & 255u) == 0u) { if (xb_ld(&(bar)[XB_TMO])) break; if (_sp > XB_SPIN_CAP) { atomicAdd(&(bar)[XB_TMO], 1u); break; } } } } while (0)
struct XcdBarrier { unsigned* bar; unsigned x; volatile LAS unsigned* st; };
DI XcdBarrier xcd_barrier_post(unsigned* bar, volatile LAS unsigned* st) {
  XcdBarrier b; b.bar = bar; b.x = xb_xcc_id(); b.st = st;
  if (threadIdx.x == 0) (void)xb_add(&bar[XB_XCNT(b.x)], 1u);
  return b;
}
DI void xcd_barrier_complete(unsigned* bar, unsigned x, unsigned& nloc, unsigned& nx) {
  const unsigned G = gridDim.x * gridDim.y * gridDim.z;
  unsigned sum, cnt, mine, sp = 0u;
  for (;;) {
    sum = 0u; cnt = 0u; mine = 0u;
#pragma unroll
    for (unsigned j = 0; j < 16; ++j) { const unsigned c = xb_ld(&bar[XB_XCNT(j)]); sum += c; cnt += (c > 0u) ? 1u : 0u; mine = (j == x) ? c : mine; }
    if (sum == G) break;
    __builtin_amdgcn_s_sleep(1);
    if ((++sp & 255u) == 0u) { if (xb_ld(&bar[XB_TMO])) break; if (sp > XB_SPIN_CAP) { atomicAdd(&bar[XB_TMO], 1u); break; } }
  }
  nloc = mine > 0u ? mine : 1u; nx = cnt > 0u ? cnt : 1u;
}
DI void xcd_barrier(const XcdBarrier& b) {
  asm volatile("s_waitcnt vmcnt(0)" ::: "memory");
  __syncthreads();
  if (threadIdx.x == 0) {
    unsigned* bar = b.bar;
    __builtin_amdgcn_s_waitcnt(0);
    unsigned nloc = b.st[0], nx = b.st[1];
    if (nloc == 0u) { xcd_barrier_complete(bar, b.x, nloc, nx); b.st[0] = nloc; b.st[1] = nx; }
    const unsigned old = xb_add(&bar[XB_XSUB(b.x)], 1u);
    const unsigned gen = old / nloc;
    if (old + 1u == (gen + 1u) * nloc) {
      __builtin_amdgcn_fence(__ATOMIC_RELEASE, "agent");
      asm volatile("s_waitcnt vmcnt(0)" ::: "memory");
      const unsigned og = xb_add(&bar[XB_TOP], 1u);
      const unsigned tg = og / nx;
      if (og + 1u == (tg + 1u) * nx) xb_add(&bar[XB_TOPGEN], 1u);
      else XB_SPIN(xb_ld(&bar[XB_TOPGEN]) == tg, bar);
      __builtin_amdgcn_fence(__ATOMIC_ACQUIRE, "agent");
      xb_add(&bar[XB_XGEN(b.x)], 1u);
      asm volatile("s_waitcnt vmcnt(0)" ::: "memory");
    } else {
      XB_SPIN(xb_ld(&bar[XB_XGEN(b.x)]) == gen, bar);
      __builtin_amdgcn_fence(__ATOMIC_ACQUIRE, "agent");
      asm volatile("s_waitcnt vmcnt(0)" ::: "memory");
    }
  }
  __syncthreads();
}

constexpr int PH_PER_LAYER = 14;
constexpr int N_PHASES = 2 * PH_PER_LAYER + 1;

template <int L>
DI void run_layer(const Params& P, const XcdBarrier& bar, char* lds, unsigned long long& tacc) {
  const bfu* Wb = (const bfu*)(P.ws + woff(L));
  const float* hc = (const float*)(P.ws + OFF_HC);
  constexpr int M2 = L == 0 ? T : TL;
  const float* s_lat = L == 0 ? P.in[I_X] : P.out;
  const float* s_ctx = L == 0 ? P.in[I_CTX] : hc;
  const int lo = P.ph_lo, hi = P.ph_hi;
#ifndef REP_MASK
#define REP_MASK 0
#endif
#ifndef REP_L
#define REP_L -1
#endif
#define PH(k, body) { const int ph_ = L * PH_PER_LAYER + (k); unsigned long long t0_ = 0; if ((TIMEMASK >> (k)) & 1) t0_ = __builtin_amdgcn_s_memrealtime(); if (lo <= ph_ && ph_ < hi) { body; if (((REP_MASK >> (k)) & 1) && (REP_L < 0 || REP_L == L)) { xcd_barrier(bar); body; } if (ph_ + 1 < hi) xcd_barrier(bar); } if ((TIMEMASK >> (k)) & 1) tacc += __builtin_amdgcn_s_memrealtime() - t0_; }
  if (L == 0) PH(0, phase_convert(P, 0, lds, 0, 704, 0))
  PH(1, phase_norm(P, L, s_lat, s_ctx, P.in[I_F1N] + L * D, 0, 1, T, ((1 + L) & 1) == 0))
  PH(2, { const bool up2_ = (int)blockIdx.x * 2 >= (int)gridDim.x;
          if (L == 0 && up2_) phase_convert(P, 0, lds, 704, 1 << 30, -1);
          phase_gemm_swiglu(P, Wb + W_WI1, T, ((2 + L) & 1) == 0, lds);
          if (L == 0 && !up2_) phase_convert(P, 0, lds, 704, 1 << 30, -1); })
  PH(3, phase_gemm_resid(P, L, (const bfu*)(P.ws + OFF_ACT), FFN, Wb + W_WO1, T, 2, 0.5f, s_lat, s_ctx, 0, nullptr, ((3 + L) & 1) == 0, lds))
  PH(4, phase_norm(P, L, P.out, hc, P.in[I_MIXN] + L * D, 3, 4, T, ((4 + L) & 1) == 0))
  PH(5, phase_gemm_win(P, L, ((5 + L) & 1) == 0, lds))
  PH(6, phase_mla_conv(P, L, lds))
  PH(7, phase_attn<0>(P, L, lds))
  PH(8, { phase_scan(P);
          const bool upper_ = (int)blockIdx.x * 2 >= (int)gridDim.x;
          if (L == 0 && upper_) phase_convert(P, 1, lds, 0, 1 << 30, 1);
          phase_attn<1>(P, L, lds);
          if (L == 0 && !upper_) phase_convert(P, 1, lds, 0, 1 << 30, 1); })
  PH(9, { phase_attn<2>(P, L, lds); phase_ssd_y(P, L, lds); })
  PH(10, phase_gemm_resid(P, L, (const bfu*)(P.ws + OFF_NBUF), D, Wb + W_WOUT, M2, 5, 1.0f, P.out, hc, 12, (const float*)(P.ws + OFF_ROWSS), ((10 + L) & 1) == 0, lds))
  PH(11, phase_norm(P, L, P.out, hc, P.in[I_F2N] + L * D, 6, 7, M2, ((11 + L) & 1) == 0))
  PH(12, phase_gemm_swiglu(P, Wb + W_WI2, M2, ((12 + L) & 1) == 0, lds))
  PH(13, phase_gemm_resid(P, L, (const bfu*)(P.ws + OFF_ACT), FFN, Wb + W_WO2, M2, 8, 0.5f, P.out, hc, 0, nullptr, ((13 + L) & 1) == 0, lds))
#undef PH
}

__global__ void __launch_bounds__(256, 2) fwd_kernel(Params P) {
  extern __shared__ __attribute__((aligned(16))) char lds[];
  __shared__ uint4 xb_words;
  cg::grid_group grid = cg::this_grid();
  if (threadIdx.x == 0) xb_words = make_uint4(0u, 0u, 0u, 0u);
  __syncthreads();
  XcdBarrier bar = xcd_barrier_post((unsigned*)(P.ws + OFF_BAR), (volatile LAS unsigned*)&xb_words);
  if (P.ph_hi > 1000) grid.sync();
  unsigned long long tacc = 0;
  run_layer<0>(P, bar, lds, tacc);
  run_layer<1>(P, bar, lds, tacc);
  if (TIMEMASK != 0) { if (blockIdx.x == 0 && threadIdx.x == 0) *(float*)(P.ws + 14336) = (float)tacc * TIMESCALE; xcd_barrier(bar); }
  if (P.ph_lo <= N_PHASES - 1 && N_PHASES - 1 < P.ph_hi) phase_final(P);
}

extern "C" void kernel_launch(void* const* d_in, const int* in_sizes, int n_in, void* d_out, int out_size, void* d_ws, size_t ws_size,
                              hipStream_t stream) {
  static int grid_blocks = 0;
  if (grid_blocks == 0) {
    if (ws_size < OFF_END) { fprintf(stderr, "kernel_launch: workspace too small: %zu < %zu\n", ws_size, (size_t)OFF_END); grid_blocks = -1; return; }
    int dev = 0, cus = 0, per_cu = 0;
    (void)hipGetDevice(&dev);
    (void)hipDeviceGetAttribute(&cus, hipDeviceAttributeMultiprocessorCount, dev);
    if (hipFuncSetAttribute((const void*)fwd_kernel, hipFuncAttributeMaxDynamicSharedMemorySize, LDS_BYTES) != hipSuccess) {
      fprintf(stderr, "kernel_launch: hipFuncSetAttribute failed\n"); grid_blocks = -1; return; }
    (void)hipOccupancyMaxActiveBlocksPerMultiprocessor(&per_cu, (const void*)fwd_kernel, 256, LDS_BYTES);
    if (per_cu < 1) { fprintf(stderr, "kernel_launch: occupancy query returned %d\n", per_cu); grid_blocks = -1; return; }
    if (per_cu > 2) per_cu = 2;
    grid_blocks = cus * per_cu;
    fprintf(stderr, "kernel_launch: grid %d (%d per CU), ws need %zu have %zu\n", grid_blocks, per_cu, (size_t)OFF_END, ws_size);
  }
  if (grid_blocks < 0) return;
  Params p{};
  for (int i = 0; i < 29; ++i) p.in[i] = (const float*)d_in[i];
  p.out = (float*)d_out; p.ws = (unsigned char*)d_ws;
#if MULTI_LAUNCH
  for (int ph = 0; ph < N_PHASES; ++ph) {
    (void)hipMemsetAsync(d_ws, 0, 16384, stream);
    p.ph_lo = ph; p.ph_hi = ph + 1;
    void* args[] = {&p};
    (void)hipLaunchCooperativeKernel((const void*)fwd_kernel, dim3(grid_blocks), dim3(256), args, LDS_BYTES, stream);
  }
#else
  (void)hipMemsetAsync(d_ws, 0, 16384, stream);
  p.ph_lo = 0; p.ph_hi = N_PHASES;
  void* args[] = {&p};
  hipError_t e = hipLaunchCooperativeKernel((const void*)fwd_kernel, dim3(grid_blocks), dim3(256), args, LDS_BYTES, stream);
  if (e != hipSuccess) fprintf(stderr, "cooperative launch failed: %s (grid %d)\n", hipGetErrorString(e), grid_blocks);
#endif
}
```
